# Optimizing an MI355X kernel written in HIP

```python
import jax, jax.numpy as jnp
from jax import lax
import numpy as np

D_MODEL = 1024
BATCH = 8
SEQ = 8192
DEPTH = 1

GRID_W = 64
CTX_LEN = 256
N_HEADS = 8
QK_NOPE = 64
QK_ROPE = 32
ROPE_AXIS = QK_ROPE // 2
V_DIM = 64
Q_LORA = 384
KV_LORA = 256
MLA_WIDTH = N_HEADS * V_DIM
POOL_WINDOWS = (2, 4, 8, 16)
POOL_GROUPS = len(POOL_WINDOWS)
POOL_WIDTH = 512
POOL_GC = POOL_WIDTH // POOL_GROUPS
D_FF = 4 * D_MODEL
IN_SPLITS = (Q_LORA,
             Q_LORA + KV_LORA,
             Q_LORA + KV_LORA + QK_ROPE,
             Q_LORA + KV_LORA + QK_ROPE + POOL_WIDTH,
             Q_LORA + KV_LORA + QK_ROPE + POOL_WIDTH + D_MODEL)
IN_WIDTH = Q_LORA + KV_LORA + QK_ROPE + POOL_WIDTH + 2 * D_MODEL
Q_BLOCK = 128
ROPE_THETA = 10000.0
NORM_EPS = 1e-6
ATTN_SCALE = (QK_NOPE + QK_ROPE) ** -0.5

kernel_name = 'hybrid_mla_pool_dit_block'


def rmsnorm(x, g):
    xf = x.astype(jnp.float32)
    y = xf * lax.rsqrt(jnp.mean(xf * xf, axis=-1, keepdims=True) + NORM_EPS)
    return (y * g.astype(jnp.float32)).astype(x.dtype)


def modulate(x, g, shift, scale):
    return rmsnorm(x, g) * (1 + scale) + shift


def adaln(cond, w_ada, b_ada):
    return jnp.split(jax.nn.silu(cond) @ w_ada + b_ada, 6, axis=-1)


def rotate(x, ang):
    half = x.shape[-1] // 2
    cos = jnp.cos(ang).astype(x.dtype)
    sin = jnp.sin(ang).astype(x.dtype)
    x1, x2 = x[..., :half], x[..., half:]
    return jnp.concatenate([x1 * cos - x2 * sin, x1 * sin + x2 * cos], axis=-1)


def axial_rope(x, ang_row, ang_col):
    return jnp.concatenate([rotate(x[..., :ROPE_AXIS], ang_row),
                            rotate(x[..., ROPE_AXIS:], ang_col)], axis=-1)


def mixer_inputs(h, w_in, q_norm_g, kv_norm_g, w_uq, w_ukv):
    b, l, _ = h.shape
    c_q, c_kv, k_rope, pool_in, g_mla, g_pool = jnp.split(h @ w_in, IN_SPLITS, axis=-1)
    q = (rmsnorm(c_q, q_norm_g) @ w_uq).reshape(b, l, N_HEADS, QK_NOPE + QK_ROPE)
    kv = (rmsnorm(c_kv, kv_norm_g) @ w_ukv).reshape(b, l, N_HEADS, QK_NOPE + V_DIM)
    q_nope, q_rope = q[..., :QK_NOPE], q[..., QK_NOPE:]
    k_nope, v = kv[..., :QK_NOPE], kv[..., QK_NOPE:]
    return q_nope, q_rope, k_nope, k_rope, v, pool_in, g_mla, g_pool


def attend(q_nope, q_rope, k_nope, k_rope, v):
    b, lq, h, _ = q_nope.shape
    nb = lq // Q_BLOCK
    qn = q_nope.reshape(b, nb, Q_BLOCK, h, QK_NOPE).swapaxes(0, 1)
    qr = q_rope.reshape(b, nb, Q_BLOCK, h, QK_ROPE).swapaxes(0, 1)

    def block(args):
        qn_b, qr_b = args
        s = (jnp.einsum('bqhd,bkhd->bhqk', qn_b, k_nope)
             + jnp.einsum('bqhr,bkr->bhqk', qr_b, k_rope))
        p = jax.nn.softmax(s.astype(jnp.float32) * ATTN_SCALE, axis=-1).astype(v.dtype)
        return jnp.einsum('bhqk,bkhd->bqhd', p, v)

    o = lax.map(block, (qn, qr))
    return o.swapaxes(0, 1).reshape(b, lq, h * V_DIM)


def multiscale_pool(u, pool_w, pool_scale):
    b, l, _ = u.shape
    uf = u.astype(jnp.float32)
    cs = jnp.concatenate([jnp.zeros((b, 1, POOL_WIDTH), jnp.float32),
                          jnp.cumsum(uf, axis=1)], axis=1)
    t = jnp.arange(l)
    outs = []
    for g, w in enumerate(POOL_WINDOWS):
        lo = jnp.clip(t - w // 2, 0, l)
        hi = jnp.clip(t + w // 2, 0, l)
        csg = cs[..., g * POOL_GC:(g + 1) * POOL_GC]
        cnt = (hi - lo).astype(jnp.float32)[None, :, None]
        outs.append((csg[:, hi] - csg[:, lo]) / cnt - uf[..., g * POOL_GC:(g + 1) * POOL_GC])
    d = jnp.stack(outs, axis=2).astype(u.dtype)
    y = jnp.einsum('blgc,gcd->blgd', d, pool_w).reshape(b, l, POOL_WIDTH)
    return y * pool_scale


def merge_branches(attn, pool_in, g_mla, g_pool, pool_w, pool_scale, w_br_mla, w_br_pool, w_out):
    pooled = multiscale_pool(pool_in, pool_w, pool_scale)
    merged = (jax.nn.sigmoid(g_mla) * (attn @ w_br_mla)
              + jax.nn.sigmoid(g_pool) * (pooled @ w_br_pool))
    return merged @ w_out


def channel_mlp(h, w1, w2):
    return jnp.square(jax.nn.relu(h @ w1)) @ w2


def setup_inputs(seed: int = 0) -> dict:
    key = jax.random.key(seed)
    ks = jax.random.split(key, 24)

    def nrm(k, shape, fan_in, s=1.0):
        return jax.random.normal(k, shape, jnp.float32) * (s * fan_in ** -0.5)

    def gain(k, shape):
        return 1.0 + 0.05 * jax.random.normal(k, shape, jnp.float32)

    L = DEPTH
    return {
        'x': jax.random.normal(ks[0], (BATCH, SEQ, D_MODEL), jnp.float32),
        'c': jax.random.normal(ks[1], (BATCH, D_MODEL), jnp.float32),
        'ctx': jax.random.normal(ks[2], (BATCH, CTX_LEN, D_MODEL), jnp.float32),
        'c_ctx': jax.random.normal(ks[3], (D_MODEL,), jnp.float32),
        'w_ada': nrm(ks[4], (L, D_MODEL, 6 * D_MODEL), D_MODEL, 0.5),
        'b_ada': 0.02 * jax.random.normal(ks[5], (L, 6 * D_MODEL), jnp.float32),
        'norm1_g': gain(ks[6], (L, D_MODEL)),
        'w_in': nrm(ks[7], (L, D_MODEL, IN_WIDTH), D_MODEL),
        'q_norm_g': gain(ks[8], (L, Q_LORA)),
        'kv_norm_g': gain(ks[9], (L, KV_LORA)),
        'w_uq': nrm(ks[10], (L, Q_LORA, N_HEADS * (QK_NOPE + QK_ROPE)), Q_LORA),
        'w_ukv': nrm(ks[11], (L, KV_LORA, N_HEADS * (QK_NOPE + V_DIM)), KV_LORA),
        'w_br_mla': nrm(ks[12], (L, MLA_WIDTH, D_MODEL), MLA_WIDTH),
        'pool_w': nrm(ks[13], (L, POOL_GROUPS, POOL_GC, POOL_GC), POOL_GC),
        'pool_scale': gain(ks[14], (L, POOL_WIDTH)),
        'w_br_pool': nrm(ks[15], (L, POOL_WIDTH, D_MODEL), POOL_WIDTH),
        'w_out': nrm(ks[16], (L, D_MODEL, D_MODEL), D_MODEL),
        'norm2_g': gain(ks[17], (L, D_MODEL)),
        'w_mlp1': nrm(ks[18], (L, D_MODEL, D_FF), D_MODEL),
        'w_mlp2': nrm(ks[19], (L, D_FF, D_MODEL), D_FF),
        'final_g': gain(ks[20], (D_MODEL,)),
    }


def reference(x, c, ctx, c_ctx, w_ada, b_ada, norm1_g, w_in, q_norm_g, kv_norm_g, w_uq, w_ukv,
              w_br_mla, pool_w, pool_scale, w_br_pool, w_out, norm2_g, w_mlp1, w_mlp2, final_g):
    seq_len = x.shape[1]
    n_rows = seq_len // GRID_W
    row = jnp.repeat(jnp.arange(n_rows, dtype=jnp.float32), GRID_W)
    col = jnp.tile(jnp.arange(GRID_W, dtype=jnp.float32), n_rows)
    inv_freq = ROPE_THETA ** (-jnp.arange(0, ROPE_AXIS, 2, dtype=jnp.float32) / ROPE_AXIS)
    ang_row = row[:, None] * inv_freq
    ang_col = col[:, None] * inv_freq

    for i in range(DEPTH):
        sh1, sc1, gt1, sh2, sc2, gt2 = adaln(c, w_ada[i], b_ada[i])
        csh1, csc1, cgt1, csh2, csc2, cgt2 = adaln(c_ctx, w_ada[i], b_ada[i])

        h_ctx = modulate(ctx, norm1_g[i], csh1, csc1)
        qn_c, qr_c, kn_c, kr_c, v_c, pool_c, gm_c, gp_c = mixer_inputs(
            h_ctx, w_in[i], q_norm_g[i], kv_norm_g[i], w_uq[i], w_ukv[i])

        h = modulate(x, norm1_g[i], sh1[:, None], sc1[:, None])
        qn, qr, kn, kr, v, pool_x, gm, gp = mixer_inputs(
            h, w_in[i], q_norm_g[i], kv_norm_g[i], w_uq[i], w_ukv[i])
        qr = axial_rope(qr, ang_row[None, :, None], ang_col[None, :, None])
        kr = axial_rope(kr, ang_row[None], ang_col[None])

        attn = attend(qn, qr,
                      jnp.concatenate([kn_c, kn], axis=1),
                      jnp.concatenate([kr_c, kr], axis=1),
                      jnp.concatenate([v_c, v], axis=1))
        x = x + gt1[:, None] * merge_branches(attn, pool_x, gm, gp, pool_w[i], pool_scale[i],
                                              w_br_mla[i], w_br_pool[i], w_out[i])
        h2 = modulate(x, norm2_g[i], sh2[:, None], sc2[:, None])
        x = x + gt2[:, None] * channel_mlp(h2, w_mlp1[i], w_mlp2[i])

        if i < DEPTH - 1:
            attn_c = attend(qn_c, qr_c, kn_c, kr_c, v_c)
            ctx = ctx + cgt1 * merge_branches(attn_c, pool_c, gm_c, gp_c, pool_w[i], pool_scale[i],
                                              w_br_mla[i], w_br_pool[i], w_out[i])
            h2c = modulate(ctx, norm2_g[i], csh2, csc2)
            ctx = ctx + cgt2 * channel_mlp(h2c, w_mlp1[i], w_mlp2[i])

    return rmsnorm(x, final_g)
```

```cpp
#include <hip/hip_runtime.h>
#include <hip/hip_bf16.h>
#include <hip/hip_cooperative_groups.h>
#include <cstdio>
#include <cstdint>
namespace cg = cooperative_groups;

#ifndef REP4
#define REP4 1
#endif
#ifndef REP7
#define REP7 1
#endif
#ifndef REP2
#define REP2 1
#endif
#ifndef MK_COOP
#define MK_COOP 1
#endif

#define LAS __attribute__((address_space(3)))
typedef unsigned short bf16_t;
typedef short bf16x8 __attribute__((ext_vector_type(8)));
typedef short s16x4 __attribute__((ext_vector_type(4)));
typedef float f32x4 __attribute__((ext_vector_type(4)));
typedef float f32x2 __attribute__((ext_vector_type(2)));
typedef float f32x16 __attribute__((ext_vector_type(16)));
typedef unsigned u32x4 __attribute__((ext_vector_type(4)));
typedef unsigned u32x2 __attribute__((ext_vector_type(2)));

constexpr int DM = 1024, NB = 8, SEQ = 8192, CTXL = 256, EXT = SEQ + CTXL, MEXT = NB * EXT, MLAT = NB * SEQ;
constexpr int NH = 8, QKD = 96, QW = NH * QKD  , VW = 512, DFF = 4096;
constexpr int NWIN = 3328;
constexpr int YW = 1280;
constexpr int GW8 = 2048;
constexpr int Y_CQ = 0, Y_KR = 384, Y_CKV = 512, Y_POOL = 768, Y_GM = 1280, Y_GP = 2304;
constexpr float EPS = 1e-6f;
constexpr float QSCALE_LOG2E = 0.10206207261596575f * 1.4426950408889634f;
constexpr int NPHASE = 9;
constexpr int LDS_BYTES = 147456;

constexpr size_t KiB = 1024, MiB = 1024 * 1024;
constexpr size_t WS_R3_ = 296 * MiB;
constexpr size_t WS_MOD = 0, WS_BIAS2 = 256 * KiB, WS_SSQQ = 384 * KiB, WS_SSQKV = 656 * KiB, WS_SSQ2 = 928 * KiB, WS_SSQ3 = 1200 * KiB, ZERO_BYTES = 1536 * KiB;
constexpr size_t WS_BAR = 1472 * KiB;
constexpr size_t WS_XCNT = 1488 * KiB;
constexpr size_t WS_XBUF = WS_R3_;
constexpr size_t WS_TAB = 1536 * KiB;
constexpr size_t WS_WIN = 2 * MiB, WS_WUQ = 9 * MiB, WS_WUKV = 10 * MiB, WS_WBM = 11 * MiB, WS_WPP = 12 * MiB, WS_WOUT = 13 * MiB, WS_W1 = 15 * MiB, WS_W2 = 23 * MiB;
constexpr size_t WS_R1 = 32 * MiB;
constexpr size_t WS_H = WS_R1, WS_Q = WS_R1, WS_K = WS_R1 + 99 * MiB, WS_V = WS_R1 + 198 * MiB, WS_MERGED = WS_R1;
constexpr size_t WS_R3 = 296 * MiB;
constexpr size_t WS_DPOOL = WS_R3, WS_ATTN = WS_R3 + 66 * MiB, WS_X1S = WS_R3;
constexpr size_t WS_R2 = 428 * MiB;
constexpr size_t WS_Y = WS_R2, WS_G8 = WS_R2 + 166 * MiB, WS_U = WS_R2;
constexpr size_t WS_END = 956 * MiB;
static_assert((size_t)MEXT * 1024 * 2 == 132 * MiB && (size_t)MEXT * 768 * 2 == 99 * MiB && (size_t)MEXT * 512 * 2 == 66 * MiB, "sizes");
static_assert((size_t)MEXT * DFF * 2 == 528 * MiB && (size_t)MEXT * YW * 2 <= 166 * MiB && (size_t)MEXT * GW8 == 132 * MiB, "sizes");

struct Args { const float* in[21]; float* out; unsigned char* ws; int ph_lo, ph_hi; };

__device__ __forceinline__ unsigned cvt_pk_bf16(float lo, float hi) { unsigned r; asm volatile("v_cvt_pk_bf16_f32 %0, %1, %2" : "=v"(r) : "v"(lo), "v"(hi)); return r; }
__device__ __forceinline__ float bf_lo(unsigned w) { return __uint_as_float(w << 16); }
__device__ __forceinline__ float bf_hi(unsigned w) { return __uint_as_float(w & 0xffff0000u); }
__device__ __forceinline__ float wave_sum(float v) {
#pragma unroll
    for (int o = 1; o < 64; o <<= 1) v += __shfl_xor(v, o);
    return v;
}
__device__ __forceinline__ float sigmoidf_(float x) { return __builtin_amdgcn_rcpf(1.f + __expf(-x)); }
__device__ __forceinline__ u32x4 pack8(f32x4 a, f32x4 b) { u32x4 w; w.x = cvt_pk_bf16(a[0], a[1]); w.y = cvt_pk_bf16(a[2], a[3]); w.z = cvt_pk_bf16(b[0], b[1]); w.w = cvt_pk_bf16(b[2], b[3]); return w; }
__device__ __forceinline__ void unpack8(u32x4 w, f32x4& a, f32x4& b) { a = (f32x4){bf_lo(w.x), bf_hi(w.x), bf_lo(w.y), bf_hi(w.y)}; b = (f32x4){bf_lo(w.z), bf_hi(w.z), bf_lo(w.w), bf_hi(w.w)}; }

namespace pg8 {
constexpr int BM = 256, BK = 64, HALF = 128, HTB = HALF * BK * 2, STAGE_BYTES = 8 * HTB, NXCD = 8, WGM = 8;
__host__ __device__ __forceinline__ int lds_byte(int r, int c) { const int st = (r >> 4) * 2 + (c >> 5), rr = r & 15, cc = c & 31, ob = rr * 64 + cc * 2; return st * 1024 + (ob ^ (((ob >> 9) & 1) << 5)); }
__host__ __device__ __forceinline__ void stage_rc(int b, int& R, int& C) { const int st = b / 1024, sb = b % 1024, swz = sb ^ (((sb >> 9) & 1) << 5); R = (st >> 1) * 16 + swz / 64; C = (st & 1) * 32 + (swz % 64) / 2; }
__host__ __device__ __forceinline__ int perm32(int rho) { const int n = rho >> 4, i = rho & 15; return 8 * (i >> 2) + 4 * n + (i & 3); }

struct Unit { int pm, pn, rnd; };
struct Gemm { const bf16_t* A; const bf16_t* Bt; int lda, K; };

struct Order {
    int nM, nN, nwg, G, c, latent;
    __device__ void init(int nM_, int nN_, int G_, int c_, int latent_) { nM = nM_; nN = nN_; nwg = nM * nN; G = G_; c = c_; latent = latent_; }
    __device__ bool next(int i, Unit& u) const {
        const long L = (long)i * G + c; if (L >= nwg) return false;
        int wgid = (int)L; { const int q = nwg / NXCD, r = nwg % NXCD, xcd = wgid % NXCD, off = wgid / NXCD; wgid = (xcd < r ? xcd * (q + 1) : r * (q + 1) + (xcd - r) * q) + off; }
        const int nig = WGM * nN, gid = wgid / nig, fm = gid * WGM, gsz = (nM - fm) < WGM ? (nM - fm) : WGM;
        int pm = fm + ((wgid % nig) % gsz); u.pn = (wgid % nig) / gsz;
        u.pm = latent ? pm + (pm >> 5) + 1 : pm; u.rnd = i; return true;
    }
};

template <class Epi, class Sched>
__device__ __forceinline__ void gemm_phase(LAS unsigned char* lds, const Gemm g, const Sched& S, const Epi& E) {
    int tid_ = threadIdx.x; asm volatile("" : "+v"(tid_));
    const int tid = tid_, wid = __builtin_amdgcn_readfirstlane(tid >> 6), lane = tid & 63, wr = wid >> 2, wc = wid & 3, fr = lane & 15, fq = lane >> 4;
    const int K = g.K, nt = K / BK, lda = g.lda;
    unsigned voffA[2], voffB[2];
#pragma unroll
    for (int i = 0; i < 2; ++i) { int R, C; stage_rc(tid * 16 + i * 8192, R, C); const int Rb = (R & ~31) + perm32(R & 31);
        voffA[i] = (unsigned)(R * lda + C) * 2u; voffB[i] = (unsigned)(Rb * K + C) * 2u; }
    const size_t kstep = (size_t)(BK * 2);
    const size_t hstepA = (size_t)HALF * lda * 2, hstepB = (size_t)HALF * K * 2;
    const size_t tstepA = 2 * hstepA, tstepB = 2 * hstepB;
    const unsigned ldsw = (unsigned)wid * 1024u;
    const int aoff = lds_byte(wr * 64 + fr, fq * 8), boff = lds_byte(wc * 32 + fr, fq * 8);
#define PG8_SA(b, h) (((b) * 2 + (h)) * HTB)
#define PG8_SB(b, h) ((4 + (b) * 2 + (h)) * HTB)
#define PG8_STAGE(bufoff, gbase, voff) do { _Pragma("unroll") for (int _i = 0; _i < 2; ++_i) \
        __builtin_amdgcn_global_load_lds((const unsigned*)((const char*)(gbase) + (voff)[_i]), (LAS unsigned*)(lds + (bufoff) + ldsw + _i * 8192), 16, 0, 0); } while (0)
#define PG8_LDA(dst, b, h) do { _Pragma("unroll") for (int m = 0; m < 4; ++m) _Pragma("unroll") for (int k = 0; k < 2; ++k) dst[m][k] = *(const LAS bf16x8*)(lds + PG8_SA(b, h) + aoff + m * 2048 + k * 1024); } while (0)
#define PG8_LDB(dst, b, h) do { _Pragma("unroll") for (int n = 0; n < 2; ++n) _Pragma("unroll") for (int k = 0; k < 2; ++k) dst[n][k] = *(const LAS bf16x8*)(lds + PG8_SB(b, h) + boff + n * 2048 + k * 1024); } while (0)
#define PG8_MMA(ai, bj, At, Bt) do { __builtin_amdgcn_s_setprio(1); _Pragma("unroll") for (int m = 0; m < 4; ++m) _Pragma("unroll") for (int n = 0; n < 2; ++n) _Pragma("unroll") for (int k = 0; k < 2; ++k) \
        acc[ai][bj][m][n] = __builtin_amdgcn_mfma_f32_16x16x32_bf16(Bt[n][k], At[m][k], acc[ai][bj][m][n], 0, 0, 0); __builtin_amdgcn_s_setprio(0); } while (0)
#define PG8_WAIT_V(n) asm volatile("s_waitcnt vmcnt(" #n ")" ::: "memory")
#define PG8_WAIT_L(n) asm volatile("s_waitcnt lgkmcnt(" #n ")" ::: "memory")
#define PG8_BAR __builtin_amdgcn_s_barrier()
#define PG8_SCHED __builtin_amdgcn_sched_barrier(0)
    Unit cur, nxt; int ui = 0;
    if (!S.next(0, cur)) return;
    f32x4 acc[2][2][4][2];
#pragma unroll
    for (int a = 0; a < 2; ++a)
#pragma unroll
        for (int b = 0; b < 2; ++b)
#pragma unroll
            for (int m = 0; m < 4; ++m)
#pragma unroll
                for (int n = 0; n < 2; ++n) acc[a][b][m][n] = (f32x4){0.f, 0.f, 0.f, 0.f};
    bf16x8 At[4][2], B0[2][2], B1[2][2];
    const char* cA = (const char*)g.A + (size_t)cur.pm * tstepA; const char* cB = (const char*)g.Bt + (size_t)cur.pn * tstepB;
    PG8_STAGE(PG8_SB(0, 0), cB, voffB); PG8_STAGE(PG8_SB(0, 1), cB + hstepB, voffB); PG8_STAGE(PG8_SA(0, 0), cA, voffA); PG8_STAGE(PG8_SA(0, 1), cA + hstepA, voffA);
    if (wr == 1) PG8_BAR;
    PG8_WAIT_V(2); PG8_BAR;
    PG8_STAGE(PG8_SB(1, 0), cB + kstep, voffB); PG8_STAGE(PG8_SA(1, 0), cA + kstep, voffA); PG8_STAGE(PG8_SB(1, 1), cB + hstepB + kstep, voffB);
    PG8_WAIT_V(6); PG8_BAR;
    for (;;) {
        const bool has_next = S.next(ui + 1, nxt);
        const char* nA = has_next ? (const char*)g.A + (size_t)nxt.pm * tstepA : cA; const char* nB = has_next ? (const char*)g.Bt + (size_t)nxt.pn * tstepB : cB;
#pragma unroll 1
        for (int t = 0; t < nt; t += 2) {
            const bool last = (t == nt - 2);
            const char* a1 = cA + (size_t)(t + 1) * kstep;
            const char* a2 = last ? nA : cA + (size_t)(t + 2) * kstep; const char* b2 = last ? nB : cB + (size_t)(t + 2) * kstep;
            const char* a3 = a2 + kstep; const char* b3 = b2 + kstep;
            PG8_LDB(B0, 0, 0); PG8_LDB(B1, 0, 1); PG8_SCHED; PG8_LDA(At, 0, 0); PG8_STAGE(PG8_SA(1, 1), a1 + hstepA, voffA);
            PG8_WAIT_V(8); PG8_WAIT_L(0); PG8_BAR; PG8_MMA(0, 0, At, B0); PG8_MMA(0, 1, At, B1); PG8_BAR; PG8_SCHED;
            PG8_LDA(At, 0, 1); PG8_STAGE(PG8_SB(0, 0), b2, voffB); PG8_STAGE(PG8_SB(0, 1), b2 + hstepB, voffB); PG8_STAGE(PG8_SA(0, 0), a2, voffA);
            PG8_WAIT_V(8); PG8_WAIT_L(0); PG8_BAR; PG8_MMA(1, 0, At, B0); PG8_MMA(1, 1, At, B1); PG8_BAR; PG8_SCHED;
            PG8_LDB(B0, 1, 0); PG8_LDB(B1, 1, 1); PG8_SCHED; PG8_LDA(At, 1, 0); PG8_STAGE(PG8_SA(0, 1), a2 + hstepA, voffA);
            PG8_WAIT_V(8); PG8_WAIT_L(0); PG8_BAR; PG8_MMA(0, 0, At, B0); PG8_MMA(0, 1, At, B1); PG8_BAR; PG8_SCHED;
            PG8_LDA(At, 1, 1); PG8_STAGE(PG8_SB(1, 0), b3, voffB); PG8_STAGE(PG8_SB(1, 1), b3 + hstepB, voffB); PG8_STAGE(PG8_SA(1, 0), a3, voffA);
            PG8_WAIT_V(8); PG8_WAIT_L(0); PG8_BAR; PG8_MMA(1, 0, At, B0); PG8_MMA(1, 1, At, B1); PG8_BAR; PG8_SCHED;
        }
        if (wr == 0) PG8_BAR;
        E(acc, cur, wr, wc, fr, fq);
        if (!has_next) break;
#pragma unroll
        for (int a = 0; a < 2; ++a)
#pragma unroll
            for (int b = 0; b < 2; ++b)
#pragma unroll
                for (int m = 0; m < 4; ++m)
#pragma unroll
                    for (int n = 0; n < 2; ++n) acc[a][b][m][n] = (f32x4){0.f, 0.f, 0.f, 0.f};
        cur = nxt; cA = nA; cB = nB; ++ui;
        if (wr == 1) PG8_BAR;
    }
    PG8_WAIT_V(0);
    PG8_BAR;
#undef PG8_SA
#undef PG8_SB
#undef PG8_STAGE
#undef PG8_LDA
#undef PG8_LDB
#undef PG8_MMA
#undef PG8_WAIT_V
#undef PG8_WAIT_L
#undef PG8_BAR
#undef PG8_SCHED
}

typedef f32x4 (&AccRef)[2][2][4][2];
#define EPI_ROWS(u) const int row0_ = (u).pm * BM + wr * 64 + fr; const int colb_ = (u).pn * BM + wc * 32 + 8 * fq;
#define EPI_ROW(ai, m) (row0_ + (ai) * HALF + (m) * 16)
#define EPI_COL(bj) (colb_ + (bj) * HALF)

struct EpiY { bf16_t* Y; unsigned char* G8; float* ssq_q; float* ssq_kv;
    __device__ __forceinline__ void operator()(AccRef acc, const Unit& u, int wr, int wc, int fr, int fq) const {
        EPI_ROWS(u)
        if (u.pn >= 5) {
#pragma unroll
            for (int ai = 0; ai < 2; ++ai)
#pragma unroll
                for (int m = 0; m < 4; ++m) { const int row = EPI_ROW(ai, m);
#pragma unroll
                    for (int bj = 0; bj < 2; ++bj) { const f32x4 v0 = acc[ai][bj][m][0], v1 = acc[ai][bj][m][1]; unsigned q[8];
#pragma unroll
                        for (int i = 0; i < 4; ++i) { q[i] = (unsigned)(sigmoidf_(v0[i]) * 255.f + 0.5f); q[4 + i] = (unsigned)(sigmoidf_(v1[i]) * 255.f + 0.5f); }
                        u32x2 w; w.x = q[0] | (q[1] << 8) | (q[2] << 16) | (q[3] << 24); w.y = q[4] | (q[5] << 8) | (q[6] << 16) | (q[7] << 24);
                        *(u32x2*)(G8 + (size_t)row * GW8 + (EPI_COL(bj) - 1280)) = w; } }
            return; }
        const int mode = (u.pn == 0) ? 1 : (u.pn == 1 ? 2 : (u.pn == 2 ? 3 : 0));
#pragma unroll
        for (int ai = 0; ai < 2; ++ai)
#pragma unroll
            for (int m = 0; m < 4; ++m) { const int row = EPI_ROW(ai, m); float s = 0.f;
#pragma unroll
                for (int bj = 0; bj < 2; ++bj) { const f32x4 v0 = acc[ai][bj][m][0], v1 = acc[ai][bj][m][1];
                    *(u32x4*)(Y + (size_t)row * YW + EPI_COL(bj)) = pack8(v0, v1);
                    if (mode == 1 || mode == 3 || (mode == 2 && bj == 0)) s += (v0[0] * v0[0] + v0[1] * v0[1]) + (v0[2] * v0[2] + v0[3] * v0[3]) + (v1[0] * v1[0] + v1[1] * v1[1]) + (v1[2] * v1[2] + v1[3] * v1[3]); }
                if (mode) { s += __shfl_xor(s, 16); s += __shfl_xor(s, 32); if (fq == 0) unsafeAtomicAdd((mode == 3 ? ssq_kv : ssq_q) + row, s); } }
    }
};
struct EpiQ { bf16_t* Q; const float* ssq_q;
    __device__ __forceinline__ void operator()(AccRef acc, const Unit& u, int wr, int wc, int fr, int fq) const {
        EPI_ROWS(u)
#pragma unroll
        for (int ai = 0; ai < 2; ++ai)
#pragma unroll
            for (int m = 0; m < 4; ++m) { const int row = EPI_ROW(ai, m); const float rstd = QSCALE_LOG2E / sqrtf(ssq_q[row] * (1.0f / 384.0f) + EPS);
#pragma unroll
                for (int bj = 0; bj < 2; ++bj) *(u32x4*)(Q + (size_t)row * QW + EPI_COL(bj)) = pack8(acc[ai][bj][m][0] * rstd, acc[ai][bj][m][1] * rstd); }
    }
};
struct EpiKV { bf16_t* Kb; const float* ssq_kv;
    __device__ __forceinline__ void operator()(AccRef acc, const Unit& u, int wr, int wc, int fr, int fq) const {
        EPI_ROWS(u)
        const int bt = u.pm / 33;
#pragma unroll
        for (int ai = 0; ai < 2; ++ai)
#pragma unroll
            for (int m = 0; m < 4; ++m) { const int row = EPI_ROW(ai, m); const float rstd = 1.0f / sqrtf(ssq_kv[row] * (1.0f / 256.0f) + EPS);
#pragma unroll
                for (int bj = 0; bj < 2; ++bj) { const f32x4 v0 = acc[ai][bj][m][0] * rstd, v1 = acc[ai][bj][m][1] * rstd; const int col = EPI_COL(bj);
                    const int hh = (col >> 6) & 7, dd = col & 63; const size_t hk = (size_t)((bt * NH + hh) * EXT + (row - bt * EXT));
                    const int key_ = row - bt * EXT;
                    const size_t koff_ = ((size_t)((bt * NH + hh) * (EXT / 64) + (key_ >> 6)) * 12 + (dd >> 3)) * 512 + (size_t)(key_ & 63) * 8;
                    const size_t off = (col < 512) ? koff_ : (size_t)((WS_V - WS_K) / 2) + hk * 64 + dd;
                    *(u32x4*)(Kb + off) = pack8(v0, v1); } }
    }
};
template <int SECOND> struct EpiMerge { bf16_t* Mg; const unsigned char* G8;
    __device__ __forceinline__ void operator()(AccRef acc, const Unit& u, int wr, int wc, int fr, int fq) const {
        EPI_ROWS(u)
#pragma unroll
        for (int ai = 0; ai < 2; ++ai)
#pragma unroll
            for (int m = 0; m < 4; ++m) { const int row = EPI_ROW(ai, m);
#pragma unroll
                for (int bj = 0; bj < 2; ++bj) { const int col = EPI_COL(bj); const u32x2 gq = *(const u32x2*)(G8 + (size_t)row * GW8 + (SECOND ? 1024 : 0) + col);
                    f32x4 v0 = acc[ai][bj][m][0], v1 = acc[ai][bj][m][1];
#pragma unroll
                    for (int i = 0; i < 4; ++i) { v0[i] *= (float)((gq.x >> (8 * i)) & 255u) * (1.0f / 255.0f); v1[i] *= (float)((gq.y >> (8 * i)) & 255u) * (1.0f / 255.0f); }
                    bf16_t* dst = Mg + (size_t)row * DM + col;
                    if (SECOND) { f32x4 p0, p1; unpack8(*(const u32x4*)dst, p0, p1); v0 += p0; v1 += p1; }
                    *(u32x4*)dst = pack8(v0, v1); } }
    }
};
struct EpiOut { const float* x; bf16_t* x1b; bf16_t* x1s; const float* mod; const float* g2; float* ssq2;
    __device__ __forceinline__ void operator()(AccRef acc, const Unit& u, int wr, int wc, int fr, int fq) const {
        EPI_ROWS(u)
        const int bt = u.pm / 33; const float* mb = mod + bt * 6144;
        f32x4 gt[2][2], sc[2][2];
#pragma unroll
        for (int bj = 0; bj < 2; ++bj)
#pragma unroll
            for (int n = 0; n < 2; ++n) { const int col = EPI_COL(bj) + 4 * n; gt[bj][n] = *(const f32x4*)(mb + 2048 + col);
                const f32x4 g = *(const f32x4*)(g2 + col), s2 = *(const f32x4*)(mb + 4096 + col); sc[bj][n] = g * (s2 + 1.0f); }
#pragma unroll
        for (int ai = 0; ai < 2; ++ai)
#pragma unroll
            for (int m = 0; m < 4; ++m) { const int row = EPI_ROW(ai, m); const size_t lat = (size_t)(row - CTXL * (bt + 1)); float s = 0.f;
#pragma unroll
                for (int bj = 0; bj < 2; ++bj) { const int col = EPI_COL(bj); const size_t off = lat * DM + col;
                    const f32x4 x0 = *(const f32x4*)(x + off), x1 = *(const f32x4*)(x + off + 4);
                    const f32x4 v0 = x0 + gt[bj][0] * acc[ai][bj][m][0], v1 = x1 + gt[bj][1] * acc[ai][bj][m][1];
                    *(u32x4*)(x1b + (size_t)row * DM + col) = pack8(v0, v1);
                    s += (v0[0] * v0[0] + v0[1] * v0[1]) + (v0[2] * v0[2] + v0[3] * v0[3]) + (v1[0] * v1[0] + v1[1] * v1[1]) + (v1[2] * v1[2] + v1[3] * v1[3]);
                    *(u32x4*)(x1s + (size_t)row * DM + col) = pack8(v0 * sc[bj][0], v1 * sc[bj][1]); }
                s += __shfl_xor(s, 16); s += __shfl_xor(s, 32); if (fq == 0) unsafeAtomicAdd(ssq2 + row, s); }
    }
};
struct EpiUp { bf16_t* U; const float* ssq2; const float* bias2;
    __device__ __forceinline__ void operator()(AccRef acc, const Unit& u, int wr, int wc, int fr, int fq) const {
        EPI_ROWS(u)
        const int bt = u.pm / 33; f32x4 bs[2][2];
#pragma unroll
        for (int bj = 0; bj < 2; ++bj)
#pragma unroll
            for (int n = 0; n < 2; ++n) bs[bj][n] = *(const f32x4*)(bias2 + bt * DFF + EPI_COL(bj) + 4 * n);
#pragma unroll
        for (int ai = 0; ai < 2; ++ai)
#pragma unroll
            for (int m = 0; m < 4; ++m) { const int row = EPI_ROW(ai, m); const float rstd = 1.0f / sqrtf(ssq2[row] * (1.0f / 1024.0f) + EPS);
#pragma unroll
                for (int bj = 0; bj < 2; ++bj) { f32x4 v0 = acc[ai][bj][m][0] * rstd + bs[bj][0], v1 = acc[ai][bj][m][1] * rstd + bs[bj][1];
#pragma unroll
                    for (int i = 0; i < 4; ++i) { const float a = fmaxf(v0[i], 0.f), b = fmaxf(v1[i], 0.f); v0[i] = a * a; v1[i] = b * b; }
                    *(u32x4*)(U + (size_t)row * DFF + EPI_COL(bj)) = pack8(v0, v1); } }
    }
};
struct EpiDown { float* out; const bf16_t* x1b; const float* mod; const float* fg; float* xbuf; unsigned* cnt; LAS unsigned char* lx;
    __device__ __forceinline__ void operator()(AccRef acc, const Unit& u, int wr, int wc, int fr, int fq) const {
        EPI_ROWS(u)
        const int bt = u.pm / 33; const float* mb = mod + bt * 6144;
        const int tid = threadIdx.x, wid = __builtin_amdgcn_readfirstlane(tid >> 6), lane = tid & 63;
        LAS float* P = (LAS float*)lx; LAS float* S = (LAS float*)(lx + 4096); volatile LAS unsigned* flag = (volatile LAS unsigned*)(lx + 5120);
        {   f32x4 gt[2][2];
#pragma unroll
            for (int bj = 0; bj < 2; ++bj)
#pragma unroll
                for (int n = 0; n < 2; ++n) gt[bj][n] = *(const f32x4*)(mb + 5120 + EPI_COL(bj) + 4 * n);
#pragma unroll
            for (int ai = 0; ai < 2; ++ai)
#pragma unroll
                for (int m = 0; m < 4; ++m) { const int row = EPI_ROW(ai, m); const size_t lat = (size_t)(row - CTXL * (bt + 1)); float s = 0.f;
#pragma unroll
                    for (int bj = 0; bj < 2; ++bj) { const size_t off = lat * DM + EPI_COL(bj);
                        f32x4 x0, x1; unpack8(*(const u32x4*)(x1b + (size_t)row * DM + EPI_COL(bj)), x0, x1);
                        const f32x4 v0 = x0 + gt[bj][0] * acc[ai][bj][m][0], v1 = x1 + gt[bj][1] * acc[ai][bj][m][1];
                        s += (v0[0] * v0[0] + v0[1] * v0[1]) + (v0[2] * v0[2] + v0[3] * v0[3]) + (v1[0] * v1[0] + v1[1] * v1[1]) + (v1[2] * v1[2] + v1[3] * v1[3]);
                        acc[ai][bj][m][0] = v0; acc[ai][bj][m][1] = v1; }
                    s += __shfl_xor(s, 16); s += __shfl_xor(s, 32);
                    if (fq == 0) P[(ai * HALF + wr * 64 + m * 16 + fr) * 4 + wc] = s;
                    asm volatile("" ::: "memory"); }
        }
        asm volatile("s_waitcnt lgkmcnt(0)" ::: "memory"); __builtin_amdgcn_s_barrier(); asm volatile("" ::: "memory");
        float* slot = xbuf + ((size_t)(u.rnd * (MEXT / 256) + u.pm) * 256) * 4;
        unsigned* cw = cnt + u.rnd * (MEXT / 256) + u.pm;
        if (tid < 256) { const float t4 = (P[tid * 4 + 0] + P[tid * 4 + 1]) + (P[tid * 4 + 2] + P[tid * 4 + 3]);
            __hip_atomic_store(slot + tid * 4 + u.pn, t4, __ATOMIC_RELAXED, __HIP_MEMORY_SCOPE_AGENT);
            asm volatile("s_waitcnt vmcnt(0)" ::: "memory");
            if (lane == 0) __hip_atomic_fetch_add(cw, 1u, __ATOMIC_RELAXED, __HIP_MEMORY_SCOPE_AGENT); }
        if (wid == 0) {
            unsigned sp = 0; bool dead = false;
            for (;;) { if ((unsigned)__builtin_amdgcn_readfirstlane(__hip_atomic_load(cw, __ATOMIC_RELAXED, __HIP_MEMORY_SCOPE_AGENT)) >= 16u) break;
                if (++sp > (1u << 22)) { dead = true; break; } __builtin_amdgcn_s_sleep(2); }
            __builtin_amdgcn_fence(__ATOMIC_ACQUIRE, "agent");
            if (lane == 0) flag[0] = dead ? 1u : 0u;
        }
        asm volatile("s_waitcnt vmcnt(0) lgkmcnt(0)" ::: "memory"); __builtin_amdgcn_s_barrier(); asm volatile("" ::: "memory");
        const bool bad = flag[0] != 0u;
        if (tid < 256) { float t4 = 0.f;
#pragma unroll
            for (int t = 0; t < 4; ++t) t4 += __hip_atomic_load(slot + tid * 4 + t, __ATOMIC_RELAXED, __HIP_MEMORY_SCOPE_AGENT);
            S[tid] = bad ? __builtin_nanf("") : 1.0f / sqrtf(t4 * (1.0f / DM) + EPS); }
        asm volatile("s_waitcnt vmcnt(0) lgkmcnt(0)" ::: "memory"); __builtin_amdgcn_s_barrier(); asm volatile("" ::: "memory");
        {   f32x4 fgv[2][2];
#pragma unroll
            for (int bj = 0; bj < 2; ++bj)
#pragma unroll
                for (int n = 0; n < 2; ++n) fgv[bj][n] = *(const f32x4*)(fg + EPI_COL(bj) + 4 * n);
#pragma unroll
            for (int ai = 0; ai < 2; ++ai)
#pragma unroll
                for (int m = 0; m < 4; ++m) { const int rl = ai * HALF + wr * 64 + m * 16 + fr; const float rs = S[rl]; const size_t lat = (size_t)(EPI_ROW(ai, m) - CTXL * (bt + 1));
#pragma unroll
                    for (int bj = 0; bj < 2; ++bj) { const size_t off = lat * DM + EPI_COL(bj);
                        *(f32x4*)(out + off) = acc[ai][bj][m][0] * rs * fgv[bj][0]; *(f32x4*)(out + off + 4) = acc[ai][bj][m][1] * rs * fgv[bj][1]; } }
        }
        asm volatile("s_waitcnt lgkmcnt(0)" ::: "memory"); __builtin_amdgcn_s_barrier(); asm volatile("" ::: "memory");
    }
};
}

namespace att {
using bf16 = __hip_bfloat16;
constexpr int NW = 8, QBLK = 32, KVBLK = 64;
constexpr float SCALE = 0.10206207261596575f;
constexpr float THR = 8.f;
constexpr int LDQ = QW, LDK = QKD, LDV = 64, LDO = VW;
constexpr int NSLOT = 3, KSLOT = 12288, VSLOT = 8192;
constexpr int LDS_K = 0, LDS_V = NSLOT * KSLOT, LDS_WS = LDS_V + NSLOT * VSLOT, SHM_ATTN = LDS_WS + NW * 64 * 4;
#define SBAR() __builtin_amdgcn_sched_barrier(0)
__device__ __forceinline__ int crow(int r, int hi) { return (r & 3) + 8 * (r >> 2) + 4 * hi; }
__device__ __forceinline__ unsigned cvtpk(float lo, float hi) { unsigned r; asm volatile("v_cvt_pk_bf16_f32 %0, %1, %2" : "=v"(r) : "v"(lo), "v"(hi)); return r; }
__device__ __forceinline__ bf16x8 ld8(const bf16* p) { return *reinterpret_cast<const bf16x8*>(p); }
__device__ __forceinline__ void glds16(const void* gsrc, unsigned lds_dst) { unsigned keep;
  asm volatile("s_mov_b32 %0, m0\n\ts_mov_b32 m0, %2\n\ts_nop 0\n\tglobal_load_lds_dwordx4 %1, off\n\ts_mov_b32 m0, %0" : "=&s"(keep) : "v"(gsrc), "s"(lds_dst) : "memory"); }

__device__ __forceinline__ void glds16s(unsigned voff, const void* sbase, unsigned lds_dst) { unsigned keep;
  asm volatile("s_mov_b32 %0, m0\n\ts_mov_b32 m0, %3\n\ts_nop 0\n\tglobal_load_lds_dwordx4 %1, %2\n\ts_mov_b32 m0, %0" : "=&s"(keep) : "v"(voff), "s"(sbase), "s"(lds_dst) : "memory"); }
__device__ __forceinline__ float rowmax32(const f32x16& p0, const f32x16& p1) {
  float pmax = p0[0];
#pragma unroll
  for (int r = 1; r < 16; ++r) pmax = fmaxf(pmax, p0[r]);
#pragma unroll
  for (int r = 0; r < 16; ++r) pmax = fmaxf(pmax, p1[r]);
  auto rr = __builtin_amdgcn_permlane32_swap(__float_as_uint(pmax), __float_as_uint(pmax), false, false);
  return fmaxf(__uint_as_float(rr[0]), __uint_as_float(rr[1]));
}
constexpr float THR2 = THR * 1.4426950408889634f;
__device__ __forceinline__ void decide(const f32x16& p0, const f32x16& p1, float& mhat, f32x16& negm, float& alpha) {
  const float pmax = rowmax32(p0, p1);
  if (__builtin_expect(__all(pmax <= THR2), 1)) { alpha = 1.f; }
  else { const float dl = fmaxf(pmax, 0.f); mhat += dl;
#pragma unroll
    for (int r = 0; r < 16; ++r) negm[r] = -mhat;
    alpha = __builtin_amdgcn_exp2f(-dl); }
}
__device__ __forceinline__ bool guard(float ps, float& mhat, f32x16& negm) {
  constexpr float BIG = 1073741824.f;
  if (__builtin_expect(__all(ps <= BIG), 1)) return false;
  mhat += 30.f;
#pragma unroll
  for (int r = 0; r < 16; ++r) negm[r] = -mhat;
  return true;
}
__device__ __forceinline__ void exps32(f32x16& p0, f32x16& p1) {
#pragma unroll
  for (int r = 0; r < 16; ++r) p0[r] = __builtin_amdgcn_exp2f(p0[r]);
#pragma unroll
  for (int r = 0; r < 16; ++r) p1[r] = __builtin_amdgcn_exp2f(p1[r]);
}
__device__ __forceinline__ void finishP(const f32x16& p0, const f32x16& p1, float alpha, float& l_reg, bf16x8& pa0, bf16x8& pa1, bf16x8& pa2, bf16x8& pa3, float& ps_out) {
  float ps = 0, ps2 = 0;
#pragma unroll
  for (int r = 0; r < 16; ++r) ps += p0[r];
#pragma unroll
  for (int r = 0; r < 16; ++r) ps2 += p1[r];
  ps += ps2;
  l_reg += ps; ps_out = ps; (void)alpha;
#define PK4(P, BASE, OUT) do { unsigned a0 = cvtpk(P[BASE + 0], P[BASE + 1]), a1 = cvtpk(P[BASE + 2], P[BASE + 3]);   \
    unsigned b0 = cvtpk(P[BASE + 4], P[BASE + 5]), b1 = cvtpk(P[BASE + 6], P[BASE + 7]);                              \
    u32x4 w = {a0, a1, b0, b1}; OUT = *reinterpret_cast<bf16x8*>(&w); } while (0)
  PK4(p0, 0, pa0); PK4(p0, 8, pa1); PK4(p1, 0, pa2); PK4(p1, 8, pa3);
#undef PK4
}
__device__ __forceinline__ void qkt(f32x16& p0, f32x16& p1, const char* Ks, const bf16x8* qr, const f32x16& negm) {
#pragma unroll
  for (int d0 = 0; d0 < 6; ++d0) {
    bf16x8 b0 = *reinterpret_cast<const bf16x8*>(Ks + d0 * 2048);
    bf16x8 b1 = *reinterpret_cast<const bf16x8*>(Ks + d0 * 2048 + 512);
    if (d0 == 0) { p0 = __builtin_amdgcn_mfma_f32_32x32x16_bf16(b0, qr[0], negm, 0, 0, 0); p1 = __builtin_amdgcn_mfma_f32_32x32x16_bf16(b1, qr[0], negm, 0, 0, 0); }
    else { p0 = __builtin_amdgcn_mfma_f32_32x32x16_bf16(b0, qr[d0], p0, 0, 0, 0); p1 = __builtin_amdgcn_mfma_f32_32x32x16_bf16(b1, qr[d0], p1, 0, 0, 0); } }
}
__device__ __forceinline__ int v_rd_base(int lane) { return ((lane & 3) << 3) | (((lane >> 2) & 3) << 6) | (((lane >> 4) & 1) << 5) | (((lane >> 5) & 1) << 8); }
constexpr int v_rd_off(int d0, int ks, int half) { return d0 * 512 + ks * 2048 + half * 1024; }
template <int OFF> __device__ __forceinline__ s16x4 tr_read(int vb) {
  s16x4 r; asm volatile("ds_read_b64_tr_b16 %0, %1 offset:%2" : "=&v"(r) : "v"(vb), "i"(OFF) : "memory"); return r;
}
struct VF { s16x4 l[2][4], h[2][4]; };
__device__ __forceinline__ void v_read(VF& f, int vb) {
#define VR(D0, KS) f.l[D0][KS] = tr_read<v_rd_off(D0, KS, 0)>(vb); f.h[D0][KS] = tr_read<v_rd_off(D0, KS, 1)>(vb);
  VR(0, 0) VR(0, 1) VR(0, 2) VR(0, 3) VR(1, 0) VR(1, 1) VR(1, 2) VR(1, 3)
#undef VR
}
__device__ __forceinline__ void v_wait(VF& f) {
  asm volatile("s_waitcnt lgkmcnt(0)" : "+v"(f.l[0][0]), "+v"(f.l[0][1]), "+v"(f.l[0][2]), "+v"(f.l[0][3]), "+v"(f.h[0][0]), "+v"(f.h[0][1]), "+v"(f.h[0][2]), "+v"(f.h[0][3]),
               "+v"(f.l[1][0]), "+v"(f.l[1][1]), "+v"(f.l[1][2]), "+v"(f.l[1][3]), "+v"(f.h[1][0]), "+v"(f.h[1][1]), "+v"(f.h[1][2]), "+v"(f.h[1][3]) :: "memory");
}
__device__ __forceinline__ void pv_mma(f32x16* o, const VF& f, bf16x8 pa0, bf16x8 pa1, bf16x8 pa2, bf16x8 pa3) {
#define PK(L, H) (bf16x8){L[0], L[1], L[2], L[3], H[0], H[1], H[2], H[3]}
#pragma unroll
  for (int d = 0; d < 2; ++d) {
    o[d] = __builtin_amdgcn_mfma_f32_32x32x16_bf16(pa0, PK(f.l[d][0], f.h[d][0]), o[d], 0, 0, 0);
    o[d] = __builtin_amdgcn_mfma_f32_32x32x16_bf16(pa1, PK(f.l[d][1], f.h[d][1]), o[d], 0, 0, 0);
    o[d] = __builtin_amdgcn_mfma_f32_32x32x16_bf16(pa2, PK(f.l[d][2], f.h[d][2]), o[d], 0, 0, 0);
    o[d] = __builtin_amdgcn_mfma_f32_32x32x16_bf16(pa3, PK(f.l[d][3], f.h[d][3]), o[d], 0, 0, 0); }
#undef PK
}

__device__ __forceinline__ void attn_unit(const bf16* __restrict__ Qb, const bf16* __restrict__ Kh, const bf16* __restrict__ Vh, bf16* __restrict__ Ob, int seq, char* lds, const float* __restrict__ tab, int t0) {
  int tid_ = threadIdx.x; asm volatile("" : "+v"(tid_));
  const int tid = tid_, lane = tid & 63, r32 = lane & 31, hi = lane >> 5; const int wid = __builtin_amdgcn_readfirstlane(tid >> 6);
  const unsigned lds0 = (unsigned)(uintptr_t)lds;
  float* ws = (float*)(lds + LDS_WS) + wid * 64; float* li_l = ws; float* al_l = ws + 32;
  float mhat = 0.f, l_reg = 0; f32x16 o[2] = {}; bf16x8 qr[6]; f32x16 negm = f32x16{}; asm volatile("" : "+v"(negm));
  const bf16* Qw = Qb + (long)(wid * QBLK + r32) * LDQ + hi * 8;
#pragma unroll
  for (int d0 = 0; d0 < 6; ++d0) qr[d0] = ld8(Qw + d0 * 16);
  { const int tq = t0 + wid * QBLK + r32;
#pragma unroll
    for (int part = 0; part < 2; ++part) { const int pos = part ? (tq & 63) : (tq >> 6); const float* tp = tab + pos * 16 + hi * 8;
      const f32x4 c0 = *(const f32x4*)tp, c1 = *(const f32x4*)(tp + 4);
      const f32x4 cs = (f32x4){c0[0], c0[2], c1[0], c1[2]}, sn = (f32x4){c0[1], c0[3], c1[1], c1[3]};
      const u32x4 w = __builtin_bit_cast(u32x4, qr[4 + part]); f32x4 x1, x2; unpack8(w, x1, x2);
      qr[4 + part] = __builtin_bit_cast(bf16x8, pack8(x1 * cs - x2 * sn, x1 * sn + x2 * cs)); } }
  const bool k2 = wid < 4;
  const unsigned koffA = (unsigned)(wid * 512 + lane * 8) * 2u, koffB = (unsigned)((8 + (wid & 3)) * 512 + lane * 8) * 2u;
  const int vkk = wid * 8 + ((lane >> 2) & 7), vkey = vkk;
  const unsigned voffV = (unsigned)(vkey * LDV + (lane >> 5) * 32 + (lane & 3) * 8) * 2u;
  const unsigned kdstA = lds0 + LDS_K + wid * 1024, kdstB = lds0 + LDS_K + (8 + (wid & 3)) * 1024, vdst = lds0 + LDS_V + wid * 1024;
#define DMA_K(t, slot) do { const bf16* kb_ = Kh + (long)(t) * KVBLK * LDK; glds16s(koffA, kb_, (unsigned)__builtin_amdgcn_readfirstlane(kdstA + (slot) * KSLOT)); \
    if (k2) glds16s(koffB, kb_, (unsigned)__builtin_amdgcn_readfirstlane(kdstB + (slot) * KSLOT)); } while (0)
#define DMA_V(t, slot) glds16s(voffV, Vh + (long)(t) * KVBLK * LDV, (unsigned)__builtin_amdgcn_readfirstlane(vdst + (slot) * VSLOT))
#define WAIT_ALL_BAR() asm volatile("s_waitcnt vmcnt(0) lgkmcnt(0)\n\ts_barrier" ::: "memory")
#define WAIT_STEP_BAR() do { if (k2) asm volatile("s_waitcnt vmcnt(3) lgkmcnt(0)\n\ts_barrier" ::: "memory"); else asm volatile("s_waitcnt vmcnt(2) lgkmcnt(0)\n\ts_barrier" ::: "memory"); } while (0)
#define RESC(tr) do { if (tr) { l_reg *= 9.313225746154785e-10f; \
    _Pragma("unroll") for (int d = 0; d < 2; ++d) _Pragma("unroll") for (int r = 0; r < 16; ++r) o[d][r] *= 9.313225746154785e-10f; } } while (0)
  const char* kp0 = lds + LDS_K + hi * 1024 + r32 * 16;
  const int vb0 = (int)(lds0 + LDS_V) + v_rd_base(lane);
  f32x16 pA0, pA1, pB0, pB1; bool alA, alB; float psum; bf16x8 pa0, pa1, pa2, pa3; VF vf; const int NT = seq / KVBLK;
  int s_prev = 2, s_cur = 0, s_next = 1;
#define ROT() do { const int t_ = s_prev; s_prev = s_cur; s_cur = s_next; s_next = t_; } while (0)
#define STEP(N0, N1, O0, O1, alN, alO, t) do { \
    const bool full_ = (t) + 2 < NT; \
    qkt(N0, N1, kp0 + s_cur * KSLOT, qr, negm); \
    finishP(O0, O1, 1.f, l_reg, pa0, pa1, pa2, pa3, psum); \
    _Pragma("unroll") for (int g_ = 0; g_ < 12; ++g_) { __builtin_amdgcn_sched_group_barrier(0x008, 1, 0); __builtin_amdgcn_sched_group_barrier(0x002, 5, 0); } \
    v_read(vf, vb0 + s_prev * VSLOT);     \
    if (full_) DMA_K((t) + 2, s_prev); if ((t) + 1 < NT) DMA_V((t) + 1, s_next);     \
    alN = guard(psum, mhat, negm); v_wait(vf); \
    pv_mma(o, vf, pa0, pa1, pa2, pa3); exps32(N0, N1); asm volatile("" : "+v"(N0), "+v"(N1)); \
    _Pragma("unroll") for (int g_ = 0; g_ < 8; ++g_) { __builtin_amdgcn_sched_group_barrier(0x008, 1, 0); __builtin_amdgcn_sched_group_barrier(0x002, 4, 0); } \
    RESC(alO); \
    if (full_) WAIT_STEP_BAR(); else WAIT_ALL_BAR(); \
    ROT(); } while (0)
  DMA_K(0, 0); DMA_V(0, 0); DMA_K(1, 1);
  WAIT_ALL_BAR();
  DMA_K(2, 2); DMA_V(1, 1);
  qkt(pA0, pA1, kp0, qr, negm);
  { const float dl = rowmax32(pA0, pA1); mhat = dl;
#pragma unroll
    for (int r = 0; r < 16; ++r) { pA0[r] -= dl; pA1[r] -= dl; }
#pragma unroll
    for (int r = 0; r < 16; ++r) negm[r] = -mhat;
    asm volatile("" : "+v"(negm)); alA = false; }
  exps32(pA0, pA1); asm volatile("" : "+v"(pA0), "+v"(pA1));
  WAIT_ALL_BAR(); ROT();
  int t = 1;
  for (; t + 1 < NT; t += 2) {
    STEP(pB0, pB1, pA0, pA1, alB, alA, t);
    STEP(pA0, pA1, pB0, pB1, alA, alB, t + 1);
  }
  STEP(pB0, pB1, pA0, pA1, alB, alA, t);
  v_read(vf, vb0 + s_prev * VSLOT);
  finishP(pB0, pB1, 1.f, l_reg, pa0, pa1, pa2, pa3, psum); v_wait(vf);
  pv_mma(o, vf, pa0, pa1, pa2, pa3);
  { auto rr = __builtin_amdgcn_permlane32_swap(__float_as_uint(l_reg), __float_as_uint(l_reg), false, false); l_reg = __uint_as_float(rr[0]) + __uint_as_float(rr[1]); }
  if (hi == 0) li_l[r32] = l_reg; asm volatile("s_waitcnt lgkmcnt(0)" ::: "memory");
  float rli[16];
#pragma unroll
  for (int r = 0; r < 16; ++r) rli[r] = __builtin_amdgcn_rcpf(li_l[crow(r, hi)]);
  bf16* Ow = Ob + (long)(wid * QBLK) * LDO;
#pragma unroll
  for (int r = 0; r < 16; ++r) { int orow = crow(r, hi);
#pragma unroll
    for (int d0 = 0; d0 < 2; ++d0) Ow[(long)orow * LDO + d0 * 32 + r32] = __float2bfloat16(o[d0][r] * rli[r]); }
  asm volatile("s_waitcnt vmcnt(0) lgkmcnt(0)\n\ts_barrier" ::: "memory");
#undef DMA_K
#undef DMA_V
#undef WAIT_ALL_BAR
#undef WAIT_STEP_BAR
#undef RESC
#undef ROT
#undef STEP
}
#undef SBAR
}


#define XB_TMO      128
#define XB_XCNT(j)  (256  + 64 * (j))
#define XB_XSUB(j)  (1280 + 64 * (j))
#define XB_XGEN(j)  (2304 + 64 * (j))
#define XB_TOP      3328
#define XB_TOPGEN   3392
#define XCD_BAR_WORDS 3456
#define XB_SPIN_CAP (1u << 22)
__device__ __forceinline__ unsigned xb_ld(unsigned* p)              { return __hip_atomic_load(p, __ATOMIC_RELAXED, __HIP_MEMORY_SCOPE_AGENT); }
__device__ __forceinline__ unsigned xb_add(unsigned* p, unsigned v) { return __hip_atomic_fetch_add(p, v, __ATOMIC_RELAXED, __HIP_MEMORY_SCOPE_AGENT); }
__device__ __forceinline__ unsigned xb_xcc_id() { return (unsigned)__builtin_amdgcn_s_getreg((3 << 11) | 20) & 0xFu; }
#define XB_SPIN(cond, bar) do { unsigned _sp = 0; while (cond) { __builtin_amdgcn_s_sleep(1); \
    if ((++_sp & 255u) == 0u) { if (xb_ld(&(bar)[XB_TMO])) break; if (_sp > XB_SPIN_CAP) { atomicAdd(&(bar)[XB_TMO], 1u); break; } } } } while (0)
struct XcdBarrier { unsigned* bar; unsigned x; volatile LAS unsigned* st; };
__device__ __forceinline__ XcdBarrier xcd_barrier_post(unsigned* bar, volatile LAS unsigned* st) {
    XcdBarrier b; b.bar = bar; b.x = xb_xcc_id(); b.st = st;
    if (threadIdx.x == 0) (void)xb_add(&bar[XB_XCNT(b.x)], 1u);
    return b;
}
__device__ __forceinline__ void xcd_barrier_complete(unsigned* bar, unsigned x, unsigned& nloc, unsigned& nx) {
    const unsigned G = gridDim.x * gridDim.y * gridDim.z;
    unsigned sum, cnt, mine, sp = 0u;
    for (;;) {
        sum = 0u; cnt = 0u; mine = 0u;
#pragma unroll
        for (unsigned j = 0; j < 16; ++j) { const unsigned c = xb_ld(&bar[XB_XCNT(j)]); sum += c; cnt += (c > 0u) ? 1u : 0u; mine = (j == x) ? c : mine; }
        if (sum == G) break;
        __builtin_amdgcn_s_sleep(1);
        if ((++sp & 255u) == 0u) { if (xb_ld(&bar[XB_TMO])) break; if (sp > XB_SPIN_CAP) { atomicAdd(&bar[XB_TMO], 1u); break; } }
    }
    nloc = mine > 0u ? mine : 1u; nx = cnt > 0u ? cnt : 1u;
}
__device__ __forceinline__ void xcd_barrier(const XcdBarrier& b) {
    asm volatile("s_waitcnt vmcnt(0)" ::: "memory");
    __syncthreads();
    if (threadIdx.x == 0) {
        unsigned* bar = b.bar;
        __builtin_amdgcn_s_waitcnt(0);
        unsigned nloc = b.st[0], nx = b.st[1];
        if (nloc == 0u) { xcd_barrier_complete(bar, b.x, nloc, nx); b.st[0] = nloc; b.st[1] = nx; }
        const unsigned old = xb_add(&bar[XB_XSUB(b.x)], 1u);
        const unsigned gen = old / nloc;
        if (old + 1u == (gen + 1u) * nloc) {
            __builtin_amdgcn_fence(__ATOMIC_RELEASE, "agent");
            asm volatile("s_waitcnt vmcnt(0)" ::: "memory");
            const unsigned og = xb_add(&bar[XB_TOP], 1u);
            const unsigned tg = og / nx;
            if (og + 1u == (tg + 1u) * nx) xb_add(&bar[XB_TOPGEN], 1u);
            else XB_SPIN(xb_ld(&bar[XB_TOPGEN]) == tg, bar);
            __builtin_amdgcn_fence(__ATOMIC_ACQUIRE, "agent");
            xb_add(&bar[XB_XGEN(b.x)], 1u);
            asm volatile("s_waitcnt vmcnt(0)" ::: "memory");
        } else {
            XB_SPIN(xb_ld(&bar[XB_XGEN(b.x)]) == gen, bar);
            __builtin_amdgcn_fence(__ATOMIC_ACQUIRE, "agent");
            asm volatile("s_waitcnt vmcnt(0)" ::: "memory");
        }
    }
    __syncthreads();
}

template <class RowMap>
__device__ __forceinline__ void transpose_item(const float* W, int K, int N, bf16_t* WT, LAS float* scr, int item, int lane, const float* kscale, RowMap rm) {
    const int nblk = N / 32, kb = item / nblk, nb = item % nblk, k0 = 64 * kb, n0 = 32 * nb;
#pragma unroll 8
    for (int i = 0; i < 32; ++i) { const int kk = 2 * i + (lane >> 5); float v = W[(size_t)(k0 + kk) * N + n0 + (lane & 31)]; if (kscale) v *= kscale[k0 + kk]; scr[kk * 33 + (lane & 31)] = v; }
    asm volatile("s_waitcnt lgkmcnt(0)" ::: "memory");
    const int c = lane & 7;
#pragma unroll
    for (int j = 0; j < 4; ++j) { const int n = (lane >> 3) + 8 * j; const LAS float* s = scr + (8 * c) * 33 + n;
        u32x4 o; o.x = cvt_pk_bf16(s[0 * 33], s[1 * 33]); o.y = cvt_pk_bf16(s[2 * 33], s[3 * 33]); o.z = cvt_pk_bf16(s[4 * 33], s[5 * 33]); o.w = cvt_pk_bf16(s[6 * 33], s[7 * 33]);
        *(u32x4*)(WT + (size_t)rm(n0 + n) * K + k0 + 8 * c) = o; }
    asm volatile("s_waitcnt lgkmcnt(0)" ::: "memory");
}
template <int NR>
__device__ __forceinline__ void gemv_item(const float* W, int N, const LAS float* sv, float* dst, const float* bias, int cgp, int ks, int lane) {
    const int col = cgp * 256 + lane * 4; f32x4 acc[NR];
#pragma unroll
    for (int b = 0; b < NR; ++b) acc[b] = (f32x4){0.f, 0.f, 0.f, 0.f};
    const float* wp = W + (size_t)(ks * 128) * N + col;
#pragma unroll 4
    for (int k = 0; k < 128; ++k) { const f32x4 w = *(const f32x4*)(wp + (size_t)k * N);
#pragma unroll
        for (int b = 0; b < NR; ++b) acc[b] += w * sv[b * 1024 + ks * 128 + k]; }
#pragma unroll
    for (int b = 0; b < NR; ++b) { if (bias && ks == 0) acc[b] += *(const f32x4*)(bias + col);
#pragma unroll
        for (int i = 0; i < 4; ++i) unsafeAtomicAdd(dst + (size_t)b * N + col + i, acc[b][i]); }
}

__global__ void __launch_bounds__(512, 2) fwd(Args a) {
    extern __shared__ __attribute__((aligned(16))) unsigned char lds_raw[];
    LAS unsigned char* lds = (LAS unsigned char*)lds_raw;
    const int tid = threadIdx.x, lane = tid & 63, wave = __builtin_amdgcn_readfirstlane(tid >> 6);
    const int G = gridDim.x, bx = blockIdx.x, gw = bx * 8 + wave, NGW = G * 8;
    unsigned char* ws = a.ws;
    float* mod = (float*)(ws + WS_MOD); float* bias2 = (float*)(ws + WS_BIAS2);
    float* ssq_q = (float*)(ws + WS_SSQQ); float* ssq_kv = (float*)(ws + WS_SSQKV); float* ssq2 = (float*)(ws + WS_SSQ2); float* ssq3 = (float*)(ws + WS_SSQ3);
    float* tab = (float*)(ws + WS_TAB);
    bf16_t* WinT = (bf16_t*)(ws + WS_WIN); bf16_t* WuqT = (bf16_t*)(ws + WS_WUQ); bf16_t* WukvT = (bf16_t*)(ws + WS_WUKV); bf16_t* WbmT = (bf16_t*)(ws + WS_WBM);
    bf16_t* WppT = (bf16_t*)(ws + WS_WPP); bf16_t* WoutT = (bf16_t*)(ws + WS_WOUT); bf16_t* W1T = (bf16_t*)(ws + WS_W1); bf16_t* W2T = (bf16_t*)(ws + WS_W2);
    bf16_t* Hb = (bf16_t*)(ws + WS_H); bf16_t* Qb = (bf16_t*)(ws + WS_Q); bf16_t* Kb = (bf16_t*)(ws + WS_K); bf16_t* Vb = (bf16_t*)(ws + WS_V); bf16_t* Mg = (bf16_t*)(ws + WS_MERGED);
    bf16_t* Dp = (bf16_t*)(ws + WS_DPOOL); bf16_t* At = (bf16_t*)(ws + WS_ATTN); bf16_t* X1s = (bf16_t*)(ws + WS_X1S);
    bf16_t* X1b = (bf16_t*)(ws + WS_R1 + 132 * MiB);
    unsigned char* G8b = ws + WS_G8;
    bf16_t* Yb = (bf16_t*)(ws + WS_Y); bf16_t* Ub = (bf16_t*)(ws + WS_U);
    const int lo = a.ph_lo, hi_ph = a.ph_hi;
#if MK_COOP
    volatile LAS unsigned* bst = (volatile LAS unsigned*)(lds + LDS_BYTES - 64);
    if (tid < 16) bst[tid] = 0u;
    __syncthreads();
    XcdBarrier bar = xcd_barrier_post((unsigned*)(ws + WS_BAR), bst);
    if (lo < 0) cg::this_grid().sync();
#endif
#ifndef PHMASK
#define PHMASK 0x1ff
#endif
#define IN(k) (((PHMASK >> (k)) & 1) && lo <= (k) && (k) < hi_ph)
#if MK_COOP
#define SEAM(k) do { if (IN(k) && IN((k) + 1)) xcd_barrier(bar); } while (0)
#else
#define SEAM(k) do { } while (0)
#endif

    if (IN(0)) {
        LAS float* sil = (LAS float*)(lds + 73728);
        for (int i = tid; i < 9 * 1024; i += 512) { const int b = i >> 10, k = i & 1023; const float v = (b < 8) ? a.in[1][b * 1024 + k] : a.in[3][k]; sil[i] = v / (1.f + __expf(-v)); }
        __syncthreads();
        LAS float* scr = (LAS float*)(lds + wave * 8448);
        constexpr int I_ADA = 24 * 8, I_PP = 1024, I_IN = 16 * 101, I_UQ = 6 * 24, I_UKV = 4 * 32, I_BM = 8 * 32, I_OUT = 16 * 32, I_W1 = 16 * 128, I_W2 = 64 * 32, I_PAD = 96, I_TAB = 1;
        constexpr int NITEMS = I_ADA + I_PP + I_IN + I_UQ + I_UKV + I_BM + I_OUT + I_W1 + I_W2 + I_PAD + I_TAB;
        auto ident = [](int n) { return n; };
        for (int it = gw; it < NITEMS; it += NGW) {
            int r = it;
            if (r < I_ADA) { gemv_item<9>(a.in[4], 6144, sil, mod, a.in[5], r >> 3, r & 7, lane); continue; } r -= I_ADA;
            if (r < I_PP) {
                const int kc = r >> 4, nb = r & 15, k0 = kc * 8, gI = k0 >> 7, c0 = k0 & 127, n = nb * 64 + lane;
                const float* pw = a.in[13] + (size_t)(gI * 128 + c0) * 128; const float* psc = a.in[14] + gI * 128; const float* wb = a.in[15] + (size_t)(gI * 128) * 1024 + n;
                float ac[8] = {0.f, 0.f, 0.f, 0.f, 0.f, 0.f, 0.f, 0.f};
#pragma unroll 4
                for (int d = 0; d < 128; ++d) { const float wv = wb[(size_t)d * 1024] * psc[d];
#pragma unroll
                    for (int i = 0; i < 8; ++i) ac[i] += pw[i * 128 + d] * wv; }
                u32x4 o; o.x = cvt_pk_bf16(ac[0], ac[1]); o.y = cvt_pk_bf16(ac[2], ac[3]); o.z = cvt_pk_bf16(ac[4], ac[5]); o.w = cvt_pk_bf16(ac[6], ac[7]);
                *(u32x4*)(WppT + (size_t)n * 512 + k0) = o; continue; } r -= I_PP;
            if (r < I_IN) { transpose_item(a.in[7], 1024, 3232, WinT, scr, r, lane, nullptr, [](int n) { return n < 384 ? n : (n < 640 ? n + 128 : (n < 672 ? n - 256 : n + 96)); }); continue; } r -= I_IN;
            if (r < I_UQ) { transpose_item(a.in[10], 384, 768, WuqT, scr, r, lane, a.in[8], [](int n) { const int d = n % 96; if (d < 64) return n; const int p = d - 64, part = p >> 4, half = (p >> 3) & 1, j = p & 7;
                                return n - d + 64 + 8 * (part * 2 + (j >> 2)) + 4 * half + (j & 3); }); continue; } r -= I_UQ;
            if (r < I_UKV) { transpose_item(a.in[11], 256, 1024, WukvT, scr, r, lane, a.in[9], [](int n) { const int h = n >> 7, e = n & 127; return e < 64 ? h * 64 + e : 512 + h * 64 + (e - 64); }); continue; } r -= I_UKV;
            if (r < I_BM) { transpose_item(a.in[12], 512, 1024, WbmT, scr, r, lane, nullptr, ident); continue; } r -= I_BM;
            if (r < I_OUT) { transpose_item(a.in[16], 1024, 1024, WoutT, scr, r, lane, nullptr, ident); continue; } r -= I_OUT;
            if (r < I_W1) { transpose_item(a.in[18], 1024, 4096, W1T, scr, r, lane, nullptr, ident); continue; } r -= I_W1;
            if (r < I_W2) { transpose_item(a.in[19], 4096, 1024, W2T, scr, r, lane, nullptr, ident); continue; } r -= I_W2;
            if (r < I_PAD) { u32x4 z = {0u, 0u, 0u, 0u}; u32x4* p = (u32x4*)(WinT + (size_t)(416 + r) * 1024); p[lane] = z; p[64 + lane] = z; continue; } r -= I_PAD;
            {
                for (int e = lane; e < 1024; e += 64) { const int pos = e >> 3, j = e & 7; const float invf = powf(10000.0f, -(float)(2 * j) / 16.0f); const float ang = (float)pos * invf;
                    tab[2 * e] = cosf(ang); tab[2 * e + 1] = sinf(ang); } }
        }
    }
    SEAM(0);

    if (IN(1)) {
        LAS float* sh2 = (LAS float*)(lds + 73728);
        for (int i = tid; i < 8 * 1024; i += 512) sh2[i] = mod[(i >> 10) * 6144 + 3072 + (i & 1023)];
        __syncthreads();
        if (gw < 128) gemv_item<8>(a.in[18], 4096, sh2, bias2, nullptr, gw >> 3, gw & 7, lane);
        const float* g1 = a.in[6];
        for (int r = gw; r < MEXT; r += NGW) {
            const int b = r / EXT, j = r - b * EXT; const bool isctx = j < CTXL;
            const float* src = isctx ? a.in[2] + (size_t)(b * CTXL + j) * DM : a.in[0] + (size_t)(b * SEQ + j - CTXL) * DM; const float* mb = mod + (isctx ? 8 : b) * 6144;
            f32x4 v[4]; float s = 0.f;
#pragma unroll
            for (int q = 0; q < 4; ++q) { v[q] = *(const f32x4*)(src + 4 * lane + 256 * q); s += (v[q][0] * v[q][0] + v[q][1] * v[q][1]) + (v[q][2] * v[q][2] + v[q][3] * v[q][3]); }
            const float rstd = 1.0f / sqrtf(wave_sum(s) * (1.0f / DM) + EPS);
#pragma unroll
            for (int q = 0; q < 4; ++q) { const int col = 4 * lane + 256 * q; const f32x4 g = *(const f32x4*)(g1 + col), sc = *(const f32x4*)(mb + 1024 + col), sh = *(const f32x4*)(mb + col);
                const f32x4 o = v[q] * rstd * g * (sc + 1.0f) + sh; u32x2 w; w.x = cvt_pk_bf16(o[0], o[1]); w.y = cvt_pk_bf16(o[2], o[3]);
                *(u32x2*)(Hb + (size_t)r * DM + col) = w; }
        }
    }
    SEAM(1);

    if (IN(2)) {
        pg8::Gemm g{Hb, WinT, DM, DM}; pg8::Order S; S.init(MEXT / 256, NWIN / 256, G, bx, 0);
        pg8::EpiY E{Yb, G8b, ssq_q, ssq_kv};
        pg8::gemm_phase(lds, g, S, E);
    }
    SEAM(2);

    if (IN(3)) {
#ifndef NO_P3A
        { pg8::Gemm g{Yb + Y_CQ, WuqT, YW, 384}; pg8::Order S; S.init(MLAT / 256, QW / 256, G, bx, 1);
          pg8::EpiQ E{Qb, ssq_q}; pg8::gemm_phase(lds, g, S, E); }
#endif
#ifndef NO_P3B
        { pg8::Gemm g{Yb + Y_CKV, WukvT, YW, 256}; pg8::Order S; S.init(MEXT / 256, 1024 / 256, G, bx, 0);
          pg8::EpiKV E{Kb, ssq_kv}; pg8::gemm_phase(lds, g, S, E); }
#endif
        const int gt = bx * 512 + tid, NTH = G * 512;
#ifndef NO_P3C
        for (int idx = gt; idx < MEXT * 4; idx += NTH) {
            const int r = idx >> 2, fq = idx & 3, b = r / EXT, j = r - b * EXT, part = fq >> 1, j0 = 4 * (fq & 1);
            const bf16_t* src = Yb + (size_t)r * YW + Y_KR + part * 16 + j0;
            const u32x2 a1 = *(const u32x2*)src, a2 = *(const u32x2*)(src + 8);
            f32x4 x1 = (f32x4){bf_lo(a1.x), bf_hi(a1.x), bf_lo(a1.y), bf_hi(a1.y)}, x2 = (f32x4){bf_lo(a2.x), bf_hi(a2.x), bf_lo(a2.y), bf_hi(a2.y)};
            if (j >= CTXL) { const int t = j - CTXL, pos = part ? (t & 63) : (t >> 6); const float* tp = tab + pos * 16 + j0 * 2;
                const f32x4 t0 = *(const f32x4*)tp, t1 = *(const f32x4*)(tp + 4);
                const f32x4 cs = (f32x4){t0[0], t0[2], t1[0], t1[2]}, sn = (f32x4){t0[1], t0[3], t1[1], t1[3]};
                const f32x4 o1 = x1 * cs - x2 * sn, o2 = x1 * sn + x2 * cs; x1 = o1; x2 = o2; }
            const u32x4 w = pack8(x1, x2);
#pragma unroll
            for (int h = 0; h < NH; ++h) *(u32x4*)(Kb + ((size_t)((b * NH + h) * (EXT / 64) + (j >> 6)) * 12 + 8 + fq) * 512 + (size_t)(j & 63) * 8) = w;
        }
#endif
#ifndef NO_P3D
        for (int idx = gt; idx < (MLAT / 32) * 64; idx += NTH) {
            const int seg = idx >> 6, ch = idx & 63, b = seg >> 8, t0 = (seg & 255) << 5, half = 1 << (ch >> 4);
            const bf16_t* base = Yb + (size_t)(b * EXT + CTXL) * YW + Y_POOL + ch * 8;
            bf16_t* dst = Dp + (size_t)(b * EXT + CTXL) * 512 + ch * 8;
            f32x4 s0 = (f32x4){0.f, 0.f, 0.f, 0.f}, s1 = s0;
            for (int sidx = max(t0 - half, 0); sidx < min(t0 + half, SEQ); ++sidx) { f32x4 p0, p1; unpack8(*(const u32x4*)(base + (size_t)sidx * YW), p0, p1); s0 += p0; s1 += p1; }
#pragma unroll 4
            for (int t = t0; t < t0 + 32; ++t) {
                const int cnt = min(t + half, SEQ) - max(t - half, 0); const float inv = 1.0f / (float)cnt;
                f32x4 c0, c1; unpack8(*(const u32x4*)(base + (size_t)t * YW), c0, c1);
                *(u32x4*)(dst + (size_t)t * 512) = pack8(s0 * inv - c0, s1 * inv - c1);
                if (t + half < SEQ) { f32x4 p0, p1; unpack8(*(const u32x4*)(base + (size_t)(t + half) * YW), p0, p1); s0 += p0; s1 += p1; }
                if (t - half >= 0) { f32x4 p0, p1; unpack8(*(const u32x4*)(base + (size_t)(t - half) * YW), p0, p1); s0 -= p0; s1 -= p1; }
            }
        }
#endif
    }
    SEAM(3);

    if (IN(4)) {
        const int xcd = bx & 7, loc = bx >> 3, per = G >> 3;
        for (int rep = 0; rep < REP4; ++rep)
        for (int i = 0; i < 8; ++i) {
            const int bh = xcd * 8 + i, b = bh >> 3, h = bh & 7;
            for (int qb = loc; qb < 32; qb += per) {
                const size_t krow0 = (size_t)b * EXT, qrow0 = krow0 + CTXL + (size_t)qb * 256;
                att::attn_unit((const att::bf16*)(Qb + qrow0 * QW + h * QKD), (const att::bf16*)(Kb + (size_t)bh * EXT * QKD), (const att::bf16*)(Vb + (size_t)bh * EXT * 64),
                               (att::bf16*)(At + qrow0 * VW + h * 64), EXT, (char*)lds_raw, tab, qb * 256);
            }
        }
    }
    SEAM(4);

    if (IN(5)) {
        { pg8::Gemm g{At, WbmT, 512, 512}; pg8::Order S; S.init(MLAT / 256, 4, G, bx, 1); pg8::EpiMerge<0> E{Mg, G8b}; pg8::gemm_phase(lds, g, S, E); }
        { pg8::Gemm g{Dp, WppT, 512, 512}; pg8::Order S; S.init(MLAT / 256, 4, G, bx, 1); pg8::EpiMerge<1> E{Mg, G8b}; pg8::gemm_phase(lds, g, S, E); }
    }
    SEAM(5);

    if (IN(6)) {
        pg8::Gemm g{Mg, WoutT, DM, DM}; pg8::Order S; S.init(MLAT / 256, 4, G, bx, 1);
        pg8::EpiOut E{a.in[0], X1b, X1s, mod, a.in[17], ssq2}; pg8::gemm_phase(lds, g, S, E);
    }
    SEAM(6);

    if (IN(7)) {
        pg8::Gemm g{X1s, W1T, DM, DM}; pg8::Order S; S.init(MLAT / 256, DFF / 256, G, bx, 1);
        pg8::EpiUp E{Ub, ssq2, bias2}; for (int rep = 0; rep < REP7; ++rep) pg8::gemm_phase(lds, g, S, E);
    }
    SEAM(7);

    if (IN(8)) {
        pg8::Gemm g{Ub, W2T, DFF, DFF}; pg8::Order S; S.init(MLAT / 256, 4, G, bx, 1);
        pg8::EpiDown E{a.out, X1b, mod, a.in[20], (float*)(ws + WS_XBUF), (unsigned*)(ws + WS_XCNT), lds + 131072}; pg8::gemm_phase(lds, g, S, E);
    }
#undef IN
#undef SEAM
}

extern "C" void kernel_launch(void* const* d_in, const int* in_sizes, int n_in, void* d_out, int out_size, void* d_ws, size_t ws_size, hipStream_t stream) {
    static int grid = 0;
    if (grid == 0) {
        if (n_in != 21 || in_sizes[0] != MLAT * DM || out_size != MLAT * DM || ws_size < WS_END) {
            fprintf(stderr, "kernel_launch: shape mismatch n_in %d in0 %d out %d ws %zu (need %zu)\n", n_in, n_in > 0 ? in_sizes[0] : -1, out_size, ws_size, (size_t)WS_END); grid = -1; return; }
        int dev = 0, cus = 0, per_cu = 0;
        hipGetDevice(&dev); hipDeviceGetAttribute(&cus, hipDeviceAttributeMultiprocessorCount, dev);
        if (hipFuncSetAttribute((const void*)fwd, hipFuncAttributeMaxDynamicSharedMemorySize, LDS_BYTES) != hipSuccess) { fprintf(stderr, "kernel_launch: hipFuncSetAttribute failed\n"); grid = -1; return; }
        if (hipOccupancyMaxActiveBlocksPerMultiprocessor(&per_cu, (const void*)fwd, 512, LDS_BYTES) != hipSuccess || per_cu < 1) { fprintf(stderr, "kernel_launch: occupancy query says %d\n", per_cu); per_cu = 1; }
        (void)hipGetLastError();
        grid = cus;
        if (grid != 256) fprintf(stderr, "kernel_launch: note: %d CUs\n", grid);
    }
    if (grid < 0) return;
    hipMemsetAsync(d_ws, 0, ZERO_BYTES, stream);
    Args a{};
    for (int i = 0; i < 21; ++i) a.in[i] = (const float*)d_in[i];
    a.out = (float*)d_out; a.ws = (unsigned char*)d_ws;
#if MK_COOP
    a.ph_lo = 0; a.ph_hi = NPHASE;
    void* args[] = {&a};
    hipError_t e = hipLaunchCooperativeKernel((const void*)fwd, dim3(grid), dim3(512), args, LDS_BYTES, stream);
    if (e != hipSuccess) fprintf(stderr, "kernel_launch: cooperative launch failed: %s (grid %d)\n", hipGetErrorString(e), grid);
#else
    for (int p = 0; p < NPHASE; ++p) { a.ph_lo = p; a.ph_hi = p + 1; hipLaunchKernelGGL(fwd, dim3(grid), dim3(512), LDS_BYTES, stream, a); }
#endif
}
```

```cpp
#include <hip/hip_runtime.h>
#include <hip/hip_bf16.h>
#include <hip/hip_cooperative_groups.h>
#include <cstdio>
#include <cstdint>
namespace cg = cooperative_groups;

#ifndef REP4
#define REP4 1
#endif
#ifndef REP7
#define REP7 1
#endif
#ifndef REP2
#define REP2 1
#endif
#ifndef MK_COOP
#define MK_COOP 1
#endif

#define LAS __attribute__((address_space(3)))
typedef unsigned short bf16_t;
typedef short bf16x8 __attribute__((ext_vector_type(8)));
typedef short s16x4 __attribute__((ext_vector_type(4)));
typedef float f32x4 __attribute__((ext_vector_type(4)));
typedef float f32x2 __attribute__((ext_vector_type(2)));
typedef float f32x16 __attribute__((ext_vector_type(16)));
typedef unsigned u32x4 __attribute__((ext_vector_type(4)));
typedef unsigned u32x2 __attribute__((ext_vector_type(2)));

constexpr int DM = 1024, NB = 8, SEQ = 8192, CTXL = 256, EXT = SEQ + CTXL, MEXT = NB * EXT, MLAT = NB * SEQ;
constexpr int NH = 8, QKD = 96, QW = NH * QKD  , VW = 512, DFF = 4096;
constexpr int NWIN = 3328;
constexpr int YW = 1280;
constexpr int GW8 = 2048;
constexpr int Y_CQ = 0, Y_KR = 384, Y_CKV = 512, Y_POOL = 768, Y_GM = 1280, Y_GP = 2304;
constexpr float EPS = 1e-6f;
constexpr float QSCALE_LOG2E = 0.10206207261596575f * 1.4426950408889634f;
constexpr int NPHASE = 9;
constexpr int LDS_BYTES = 147456;

constexpr size_t KiB = 1024, MiB = 1024 * 1024;
constexpr size_t WS_R3_ = 296 * MiB;
constexpr size_t WS_MOD = 0, WS_BIAS2 = 256 * KiB, WS_SSQQ = 384 * KiB, WS_SSQKV = 656 * KiB, WS_SSQ2 = 928 * KiB, WS_SSQ3 = 1200 * KiB, ZERO_BYTES = 1536 * KiB;
constexpr size_t WS_BAR = 1472 * KiB;
constexpr size_t WS_XCNT = 1488 * KiB;
constexpr size_t WS_XBUF = WS_R3_;
constexpr size_t WS_TAB = 1536 * KiB;
constexpr size_t WS_WIN = 2 * MiB, WS_WUQ = 9 * MiB, WS_WUKV = 10 * MiB, WS_WBM = 11 * MiB, WS_WPP = 12 * MiB, WS_WOUT = 13 * MiB, WS_W1 = 15 * MiB, WS_W2 = 23 * MiB;
constexpr size_t WS_R1 = 32 * MiB;
constexpr size_t WS_H = WS_R1, WS_Q = WS_R1, WS_K = WS_R1 + 99 * MiB, WS_V = WS_R1 + 198 * MiB, WS_MERGED = WS_R1;
constexpr size_t WS_R3 = 296 * MiB;
constexpr size_t WS_DPOOL = WS_R3, WS_ATTN = WS_R3 + 66 * MiB, WS_X1S = WS_R3;
constexpr size_t WS_R2 = 428 * MiB;
constexpr size_t WS_Y = WS_R2, WS_G8 = WS_R2 + 166 * MiB, WS_U = WS_R2;
constexpr size_t WS_END = 956 * MiB;
static_assert((size_t)MEXT * 1024 * 2 == 132 * MiB && (size_t)MEXT * 768 * 2 == 99 * MiB && (size_t)MEXT * 512 * 2 == 66 * MiB, "sizes");
static_assert((size_t)MEXT * DFF * 2 == 528 * MiB && (size_t)MEXT * YW * 2 <= 166 * MiB && (size_t)MEXT * GW8 == 132 * MiB, "sizes");

struct Args { const float* in[21]; float* out; unsigned char* ws; int ph_lo, ph_hi; };

__device__ __forceinline__ unsigned cvt_pk_bf16(float lo, float hi) { unsigned r; asm volatile("v_cvt_pk_bf16_f32 %0, %1, %2" : "=v"(r) : "v"(lo), "v"(hi)); return r; }
__device__ __forceinline__ float bf_lo(unsigned w) { return __uint_as_float(w << 16); }
__device__ __forceinline__ float bf_hi(unsigned w) { return __uint_as_float(w & 0xffff0000u); }
__device__ __forceinline__ float wave_sum(float v) {
#pragma unroll
    for (int o = 1; o < 64; o <<= 1) v += __shfl_xor(v, o);
    return v;
}
__device__ __forceinline__ float sigmoidf_(float x) { return __builtin_amdgcn_rcpf(1.f + __expf(-x)); }
__device__ __forceinline__ u32x4 pack8(f32x4 a, f32x4 b) { u32x4 w; w.x = cvt_pk_bf16(a[0], a[1]); w.y = cvt_pk_bf16(a[2], a[3]); w.z = cvt_pk_bf16(b[0], b[1]); w.w = cvt_pk_bf16(b[2], b[3]); return w; }
__device__ __forceinline__ void unpack8(u32x4 w, f32x4& a, f32x4& b) { a = (f32x4){bf_lo(w.x), bf_hi(w.x), bf_lo(w.y), bf_hi(w.y)}; b = (f32x4){bf_lo(w.z), bf_hi(w.z), bf_lo(w.w), bf_hi(w.w)}; }

namespace pg8 {
constexpr int BM = 256, BK = 64, HALF = 128, HTB = HALF * BK * 2, STAGE_BYTES = 8 * HTB, NXCD = 8, WGM = 8;
__host__ __device__ __forceinline__ int lds_byte(int r, int c) { const int st = (r >> 4) * 2 + (c >> 5), rr = r & 15, cc = c & 31, ob = rr * 64 + cc * 2; return st * 1024 + (ob ^ (((ob >> 9) & 1) << 5)); }
__host__ __device__ __forceinline__ void stage_rc(int b, int& R, int& C) { const int st = b / 1024, sb = b % 1024, swz = sb ^ (((sb >> 9) & 1) << 5); R = (st >> 1) * 16 + swz / 64; C = (st & 1) * 32 + (swz % 64) / 2; }
__host__ __device__ __forceinline__ int perm32(int rho) { const int n = rho >> 4, i = rho & 15; return 8 * (i >> 2) + 4 * n + (i & 3); }

struct Unit { int pm, pn, rnd; };
struct Gemm { const bf16_t* A; const bf16_t* Bt; int lda, K; };

struct Order {
    int nM, nN, nwg, G, c, latent;
    __device__ void init(int nM_, int nN_, int G_, int c_, int latent_) { nM = nM_; nN = nN_; nwg = nM * nN; G = G_; c = c_; latent = latent_; }
    __device__ bool next(int i, Unit& u) const {
        const long L = (long)i * G + c; if (L >= nwg) return false;
        int wgid = (int)L; { const int q = nwg / NXCD, r = nwg % NXCD, xcd = wgid % NXCD, off = wgid / NXCD; wgid = (xcd < r ? xcd * (q + 1) : r * (q + 1) + (xcd - r) * q) + off; }
        const int nig = WGM * nN, gid = wgid / nig, fm = gid * WGM, gsz = (nM - fm) < WGM ? (nM - fm) : WGM;
        int pm = fm + ((wgid % nig) % gsz); u.pn = (wgid % nig) / gsz;
        u.pm = latent ? pm + (pm >> 5) + 1 : pm; u.rnd = i; return true;
    }
};

template <class Epi, class Sched>
__device__ __forceinline__ void gemm_phase(LAS unsigned char* lds, const Gemm g, const Sched& S, const Epi& E) {
    int tid_ = threadIdx.x; asm volatile("" : "+v"(tid_));
    const int tid = tid_, wid = __builtin_amdgcn_readfirstlane(tid >> 6), lane = tid & 63, wr = wid >> 2, wc = wid & 3, fr = lane & 15, fq = lane >> 4;
    const int K = g.K, nt = K / BK, lda = g.lda;
    unsigned voffA[2], voffB[2];
#pragma unroll
    for (int i = 0; i < 2; ++i) { int R, C; stage_rc(tid * 16 + i * 8192, R, C); const int Rb = (R & ~31) + perm32(R & 31);
        voffA[i] = (unsigned)(R * lda + C) * 2u; voffB[i] = (unsigned)(Rb * K + C) * 2u; }
    const size_t kstep = (size_t)(BK * 2);
    const size_t hstepA = (size_t)HALF * lda * 2, hstepB = (size_t)HALF * K * 2;
    const size_t tstepA = 2 * hstepA, tstepB = 2 * hstepB;
    const unsigned ldsw = (unsigned)wid * 1024u;
    const int aoff = lds_byte(wr * 64 + fr, fq * 8), boff = lds_byte(wc * 32 + fr, fq * 8);
#define PG8_SA(b, h) (((b) * 2 + (h)) * HTB)
#define PG8_SB(b, h) ((4 + (b) * 2 + (h)) * HTB)
#define PG8_STAGE(bufoff, gbase, voff) do { _Pragma("unroll") for (int _i = 0; _i < 2; ++_i) \
        __builtin_amdgcn_global_load_lds((const unsigned*)((const char*)(gbase) + (voff)[_i]), (LAS unsigned*)(lds + (bufoff) + ldsw + _i * 8192), 16, 0, 0); } while (0)
#define PG8_LDA(dst, b, h) do { _Pragma("unroll") for (int m = 0; m < 4; ++m) _Pragma("unroll") for (int k = 0; k < 2; ++k) dst[m][k] = *(const LAS bf16x8*)(lds + PG8_SA(b, h) + aoff + m * 2048 + k * 1024); } while (0)
#define PG8_LDB(dst, b, h) do { _Pragma("unroll") for (int n = 0; n < 2; ++n) _Pragma("unroll") for (int k = 0; k < 2; ++k) dst[n][k] = *(const LAS bf16x8*)(lds + PG8_SB(b, h) + boff + n * 2048 + k * 1024); } while (0)
#define PG8_MMA(ai, bj, At, Bt) do { __builtin_amdgcn_s_setprio(1); _Pragma("unroll") for (int m = 0; m < 4; ++m) _Pragma("unroll") for (int n = 0; n < 2; ++n) _Pragma("unroll") for (int k = 0; k < 2; ++k) \
        acc[ai][bj][m][n] = __builtin_amdgcn_mfma_f32_16x16x32_bf16(Bt[n][k], At[m][k], acc[ai][bj][m][n], 0, 0, 0); __builtin_amdgcn_s_setprio(0); } while (0)
#define PG8_WAIT_V(n) asm volatile("s_waitcnt vmcnt(" #n ")" ::: "memory")
#define PG8_WAIT_L(n) asm volatile("s_waitcnt lgkmcnt(" #n ")" ::: "memory")
#define PG8_BAR __builtin_amdgcn_s_barrier()
#define PG8_SCHED __builtin_amdgcn_sched_barrier(0)
    Unit cur, nxt; int ui = 0;
    if (!S.next(0, cur)) return;
    f32x4 acc[2][2][4][2];
#pragma unroll
    for (int a = 0; a < 2; ++a)
#pragma unroll
        for (int b = 0; b < 2; ++b)
#pragma unroll
            for (int m = 0; m < 4; ++m)
#pragma unroll
                for (int n = 0; n < 2; ++n) acc[a][b][m][n] = (f32x4){0.f, 0.f, 0.f, 0.f};
    bf16x8 At[4][2], B0[2][2], B1[2][2];
    const char* cA = (const char*)g.A + (size_t)cur.pm * tstepA; const char* cB = (const char*)g.Bt + (size_t)cur.pn * tstepB;
    PG8_STAGE(PG8_SB(0, 0), cB, voffB); PG8_STAGE(PG8_SB(0, 1), cB + hstepB, voffB); PG8_STAGE(PG8_SA(0, 0), cA, voffA); PG8_STAGE(PG8_SA(0, 1), cA + hstepA, voffA);
    if (wr == 1) PG8_BAR;
    PG8_WAIT_V(2); PG8_BAR;
    PG8_STAGE(PG8_SB(1, 0), cB + kstep, voffB); PG8_STAGE(PG8_SA(1, 0), cA + kstep, voffA); PG8_STAGE(PG8_SB(1, 1), cB + hstepB + kstep, voffB);
    PG8_WAIT_V(6); PG8_BAR;
    for (;;) {
        const bool has_next = S.next(ui + 1, nxt);
        const char* nA = has_next ? (const char*)g.A + (size_t)nxt.pm * tstepA : cA; const char* nB = has_next ? (const char*)g.Bt + (size_t)nxt.pn * tstepB : cB;
#pragma unroll 1
        for (int t = 0; t < nt; t += 2) {
            const bool last = (t == nt - 2);
            const char* a1 = cA + (size_t)(t + 1) * kstep;
            const char* a2 = last ? nA : cA + (size_t)(t + 2) * kstep; const char* b2 = last ? nB : cB + (size_t)(t + 2) * kstep;
            const char* a3 = a2 + kstep; const char* b3 = b2 + kstep;
            PG8_LDB(B0, 0, 0); PG8_LDB(B1, 0, 1); PG8_SCHED; PG8_LDA(At, 0, 0); PG8_STAGE(PG8_SA(1, 1), a1 + hstepA, voffA);
            PG8_WAIT_V(8); PG8_WAIT_L(0); PG8_BAR; PG8_MMA(0, 0, At, B0); PG8_MMA(0, 1, At, B1); PG8_BAR; PG8_SCHED;
            PG8_LDA(At, 0, 1); PG8_STAGE(PG8_SB(0, 0), b2, voffB); PG8_STAGE(PG8_SB(0, 1), b2 + hstepB, voffB); PG8_STAGE(PG8_SA(0, 0), a2, voffA);
            PG8_WAIT_V(8); PG8_WAIT_L(0); PG8_BAR; PG8_MMA(1, 0, At, B0); PG8_MMA(1, 1, At, B1); PG8_BAR; PG8_SCHED;
            PG8_LDB(B0, 1, 0); PG8_LDB(B1, 1, 1); PG8_SCHED; PG8_LDA(At, 1, 0); PG8_STAGE(PG8_SA(0, 1), a2 + hstepA, voffA);
            PG8_WAIT_V(8); PG8_WAIT_L(0); PG8_BAR; PG8_MMA(0, 0, At, B0); PG8_MMA(0, 1, At, B1); PG8_BAR; PG8_SCHED;
            PG8_LDA(At, 1, 1); PG8_STAGE(PG8_SB(1, 0), b3, voffB); PG8_STAGE(PG8_SB(1, 1), b3 + hstepB, voffB); PG8_STAGE(PG8_SA(1, 0), a3, voffA);
            PG8_WAIT_V(8); PG8_WAIT_L(0); PG8_BAR; PG8_MMA(1, 0, At, B0); PG8_MMA(1, 1, At, B1); PG8_BAR; PG8_SCHED;
        }
        if (wr == 0) PG8_BAR;
        E(acc, cur, wr, wc, fr, fq);
        if (!has_next) break;
#pragma unroll
        for (int a = 0; a < 2; ++a)
#pragma unroll
            for (int b = 0; b < 2; ++b)
#pragma unroll
                for (int m = 0; m < 4; ++m)
#pragma unroll
                    for (int n = 0; n < 2; ++n) acc[a][b][m][n] = (f32x4){0.f, 0.f, 0.f, 0.f};
        cur = nxt; cA = nA; cB = nB; ++ui;
        if (wr == 1) PG8_BAR;
    }
    PG8_WAIT_V(0);
    PG8_BAR;
#undef PG8_SA
#undef PG8_SB
#undef PG8_STAGE
#undef PG8_LDA
#undef PG8_LDB
#undef PG8_MMA
#undef PG8_WAIT_V
#undef PG8_WAIT_L
#undef PG8_BAR
#undef PG8_SCHED
}

typedef f32x4 (&AccRef)[2][2][4][2];
#define EPI_ROWS(u) const int row0_ = (u).pm * BM + wr * 64 + fr; const int colb_ = (u).pn * BM + wc * 32 + 8 * fq;
#define EPI_ROW(ai, m) (row0_ + (ai) * HALF + (m) * 16)
#define EPI_COL(bj) (colb_ + (bj) * HALF)

struct EpiY { bf16_t* Y; unsigned char* G8; float* ssq_q; float* ssq_kv;
    __device__ __forceinline__ void operator()(AccRef acc, const Unit& u, int wr, int wc, int fr, int fq) const {
        EPI_ROWS(u)
        if (u.pn >= 5) {
#pragma unroll
            for (int ai = 0; ai < 2; ++ai)
#pragma unroll
                for (int m = 0; m < 4; ++m) { const int row = EPI_ROW(ai, m);
#pragma unroll
                    for (int bj = 0; bj < 2; ++bj) { const f32x4 v0 = acc[ai][bj][m][0], v1 = acc[ai][bj][m][1]; unsigned q[8];
#pragma unroll
                        for (int i = 0; i < 4; ++i) { q[i] = (unsigned)(sigmoidf_(v0[i]) * 255.f + 0.5f); q[4 + i] = (unsigned)(sigmoidf_(v1[i]) * 255.f + 0.5f); }
                        u32x2 w; w.x = q[0] | (q[1] << 8) | (q[2] << 16) | (q[3] << 24); w.y = q[4] | (q[5] << 8) | (q[6] << 16) | (q[7] << 24);
                        *(u32x2*)(G8 + (size_t)row * GW8 + (EPI_COL(bj) - 1280)) = w; } }
            return; }
        const int mode = (u.pn == 0) ? 1 : (u.pn == 1 ? 2 : (u.pn == 2 ? 3 : 0));
#pragma unroll
        for (int ai = 0; ai < 2; ++ai)
#pragma unroll
            for (int m = 0; m < 4; ++m) { const int row = EPI_ROW(ai, m); float s = 0.f;
#pragma unroll
                for (int bj = 0; bj < 2; ++bj) { const f32x4 v0 = acc[ai][bj][m][0], v1 = acc[ai][bj][m][1];
                    *(u32x4*)(Y + (size_t)row * YW + EPI_COL(bj)) = pack8(v0, v1);
                    if (mode == 1 || mode == 3 || (mode == 2 && bj == 0)) s += (v0[0] * v0[0] + v0[1] * v0[1]) + (v0[2] * v0[2] + v0[3] * v0[3]) + (v1[0] * v1[0] + v1[1] * v1[1]) + (v1[2] * v1[2] + v1[3] * v1[3]); }
                if (mode) { s += __shfl_xor(s, 16); s += __shfl_xor(s, 32); if (fq == 0) unsafeAtomicAdd((mode == 3 ? ssq_kv : ssq_q) + row, s); } }
    }
};
struct EpiQ { bf16_t* Q; const float* ssq_q;
    __device__ __forceinline__ void operator()(AccRef acc, const Unit& u, int wr, int wc, int fr, int fq) const {
        EPI_ROWS(u)
#pragma unroll
        for (int ai = 0; ai < 2; ++ai)
#pragma unroll
            for (int m = 0; m < 4; ++m) { const int row = EPI_ROW(ai, m); const float rstd = QSCALE_LOG2E / sqrtf(ssq_q[row] * (1.0f / 384.0f) + EPS);
#pragma unroll
                for (int bj = 0; bj < 2; ++bj) *(u32x4*)(Q + (size_t)row * QW + EPI_COL(bj)) = pack8(acc[ai][bj][m][0] * rstd, acc[ai][bj][m][1] * rstd); }
    }
};
struct EpiKV { bf16_t* Kb; const float* ssq_kv;
    __device__ __forceinline__ void operator()(AccRef acc, const Unit& u, int wr, int wc, int fr, int fq) const {
        EPI_ROWS(u)
        const int bt = u.pm / 33;
#pragma unroll
        for (int ai = 0; ai < 2; ++ai)
#pragma unroll
            for (int m = 0; m < 4; ++m) { const int row = EPI_ROW(ai, m); const float rstd = 1.0f / sqrtf(ssq_kv[row] * (1.0f / 256.0f) + EPS);
#pragma unroll
                for (int bj = 0; bj < 2; ++bj) { const f32x4 v0 = acc[ai][bj][m][0] * rstd, v1 = acc[ai][bj][m][1] * rstd; const int col = EPI_COL(bj);
                    const int hh = (col >> 6) & 7, dd = col & 63; const size_t hk = (size_t)((bt * NH + hh) * EXT + (row - bt * EXT));
                    const int key_ = row - bt * EXT;
                    const size_t koff_ = ((size_t)((bt * NH + hh) * (EXT / 64) + (key_ >> 6)) * 12 + (dd >> 3)) * 512 + (size_t)(key_ & 63) * 8;
                    const size_t off = (col < 512) ? koff_ : (size_t)((WS_V - WS_K) / 2) + hk * 64 + dd;
                    *(u32x4*)(Kb + off) = pack8(v0, v1); } }
    }
};
template <int SECOND> struct EpiMerge { bf16_t* Mg; const unsigned char* G8;
    __device__ __forceinline__ void operator()(AccRef acc, const Unit& u, int wr, int wc, int fr, int fq) const {
        EPI_ROWS(u)
#pragma unroll
        for (int ai = 0; ai < 2; ++ai)
#pragma unroll
            for (int m = 0; m < 4; ++m) { const int row = EPI_ROW(ai, m);
#pragma unroll
                for (int bj = 0; bj < 2; ++bj) { const int col = EPI_COL(bj); const u32x2 gq = *(const u32x2*)(G8 + (size_t)row * GW8 + (SECOND ? 1024 : 0) + col);
                    f32x4 v0 = acc[ai][bj][m][0], v1 = acc[ai][bj][m][1];
#pragma unroll
                    for (int i = 0; i < 4; ++i) { v0[i] *= (float)((gq.x >> (8 * i)) & 255u) * (1.0f / 255.0f); v1[i] *= (float)((gq.y >> (8 * i)) & 255u) * (1.0f / 255.0f); }
                    bf16_t* dst = Mg + (size_t)row * DM + col;
                    if (SECOND) { f32x4 p0, p1; unpack8(*(const u32x4*)dst, p0, p1); v0 += p0; v1 += p1; }
                    *(u32x4*)dst = pack8(v0, v1); } }
    }
};
struct EpiOut { const float* x; bf16_t* x1b; bf16_t* x1s; const float* mod; const float* g2; float* ssq2;
    __device__ __forceinline__ void operator()(AccRef acc, const Unit& u, int wr, int wc, int fr, int fq) const {
        EPI_ROWS(u)
        const int bt = u.pm / 33; const float* mb = mod + bt * 6144;
        f32x4 gt[2][2], sc[2][2];
#pragma unroll
        for (int bj = 0; bj < 2; ++bj)
#pragma unroll
            for (int n = 0; n < 2; ++n) { const int col = EPI_COL(bj) + 4 * n; gt[bj][n] = *(const f32x4*)(mb + 2048 + col);
                const f32x4 g = *(const f32x4*)(g2 + col), s2 = *(const f32x4*)(mb + 4096 + col); sc[bj][n] = g * (s2 + 1.0f); }
#pragma unroll
        for (int ai = 0; ai < 2; ++ai)
#pragma unroll
            for (int m = 0; m < 4; ++m) { const int row = EPI_ROW(ai, m); const size_t lat = (size_t)(row - CTXL * (bt + 1)); float s = 0.f;
#pragma unroll
                for (int bj = 0; bj < 2; ++bj) { const int col = EPI_COL(bj); const size_t off = lat * DM + col;
                    const f32x4 x0 = *(const f32x4*)(x + off), x1 = *(const f32x4*)(x + off + 4);
                    const f32x4 v0 = x0 + gt[bj][0] * acc[ai][bj][m][0], v1 = x1 + gt[bj][1] * acc[ai][bj][m][1];
                    *(u32x4*)(x1b + (size_t)row * DM + col) = pack8(v0, v1);
                    s += (v0[0] * v0[0] + v0[1] * v0[1]) + (v0[2] * v0[2] + v0[3] * v0[3]) + (v1[0] * v1[0] + v1[1] * v1[1]) + (v1[2] * v1[2] + v1[3] * v1[3]);
                    *(u32x4*)(x1s + (size_t)row * DM + col) = pack8(v0 * sc[bj][0], v1 * sc[bj][1]); }
                s += __shfl_xor(s, 16); s += __shfl_xor(s, 32); if (fq == 0) unsafeAtomicAdd(ssq2 + row, s); }
    }
};
struct EpiUp { bf16_t* U; const float* ssq2; const float* bias2;
    __device__ __forceinline__ void operator()(AccRef acc, const Unit& u, int wr, int wc, int fr, int fq) const {
        EPI_ROWS(u)
        const int bt = u.pm / 33; f32x4 bs[2][2];
#pragma unroll
        for (int bj = 0; bj < 2; ++bj)
#pragma unroll
            for (int n = 0; n < 2; ++n) bs[bj][n] = *(const f32x4*)(bias2 + bt * DFF + EPI_COL(bj) + 4 * n);
#pragma unroll
        for (int ai = 0; ai < 2; ++ai)
#pragma unroll
            for (int m = 0; m < 4; ++m) { const int row = EPI_ROW(ai, m); const float rstd = 1.0f / sqrtf(ssq2[row] * (1.0f / 1024.0f) + EPS);
#pragma unroll
                for (int bj = 0; bj < 2; ++bj) { f32x4 v0 = acc[ai][bj][m][0] * rstd + bs[bj][0], v1 = acc[ai][bj][m][1] * rstd + bs[bj][1];
#pragma unroll
                    for (int i = 0; i < 4; ++i) { const float a = fmaxf(v0[i], 0.f), b = fmaxf(v1[i], 0.f); v0[i] = a * a; v1[i] = b * b; }
                    *(u32x4*)(U + (size_t)row * DFF + EPI_COL(bj)) = pack8(v0, v1); } }
    }
};
struct EpiDown { float* out; const bf16_t* x1b; const float* mod; const float* fg; float* xbuf; unsigned* cnt; LAS unsigned char* lx;
    __device__ __forceinline__ void operator()(AccRef acc, const Unit& u, int wr, int wc, int fr, int fq) const {
        EPI_ROWS(u)
        const int bt = u.pm / 33; const float* mb = mod + bt * 6144;
        const int tid = threadIdx.x, wid = __builtin_amdgcn_readfirstlane(tid >> 6), lane = tid & 63;
        LAS float* P = (LAS float*)lx; LAS float* S = (LAS float*)(lx + 4096); volatile LAS unsigned* flag = (volatile LAS unsigned*)(lx + 5120);
        {   f32x4 gt[2][2];
#pragma unroll
            for (int bj = 0; bj < 2; ++bj)
#pragma unroll
                for (int n = 0; n < 2; ++n) gt[bj][n] = *(const f32x4*)(mb + 5120 + EPI_COL(bj) + 4 * n);
#pragma unroll
            for (int ai = 0; ai < 2; ++ai)
#pragma unroll
                for (int m = 0; m < 4; ++m) { const int row = EPI_ROW(ai, m); const size_t lat = (size_t)(row - CTXL * (bt + 1)); float s = 0.f;
#pragma unroll
                    for (int bj = 0; bj < 2; ++bj) { const size_t off = lat * DM + EPI_COL(bj);
                        f32x4 x0, x1; unpack8(*(const u32x4*)(x1b + (size_t)row * DM + EPI_COL(bj)), x0, x1);
                        const f32x4 v0 = x0 + gt[bj][0] * acc[ai][bj][m][0], v1 = x1 + gt[bj][1] * acc[ai][bj][m][1];
                        s += (v0[0] * v0[0] + v0[1] * v0[1]) + (v0[2] * v0[2] + v0[3] * v0[3]) + (v1[0] * v1[0] + v1[1] * v1[1]) + (v1[2] * v1[2] + v1[3] * v1[3]);
                        acc[ai][bj][m][0] = v0; acc[ai][bj][m][1] = v1; }
                    s += __shfl_xor(s, 16); s += __shfl_xor(s, 32);
                    if (fq == 0) P[(ai * HALF + wr * 64 + m * 16 + fr) * 4 + wc] = s;
                    asm volatile("" ::: "memory"); }
        }
        asm volatile("s_waitcnt lgkmcnt(0)" ::: "memory"); __builtin_amdgcn_s_barrier(); asm volatile("" ::: "memory");
        float* slot = xbuf + ((size_t)(u.rnd * (MEXT / 256) + u.pm) * 256) * 4;
        unsigned* cw = cnt + u.rnd * (MEXT / 256) + u.pm;
        if (tid < 256) { const float t4 = (P[tid * 4 + 0] + P[tid * 4 + 1]) + (P[tid * 4 + 2] + P[tid * 4 + 3]);
            __hip_atomic_store(slot + tid * 4 + u.pn, t4, __ATOMIC_RELAXED, __HIP_MEMORY_SCOPE_AGENT);
            asm volatile("s_waitcnt vmcnt(0)" ::: "memory");
            if (lane == 0) __hip_atomic_fetch_add(cw, 1u, __ATOMIC_RELAXED, __HIP_MEMORY_SCOPE_AGENT); }
        if (wid == 0) {
            unsigned sp = 0; bool dead = false;
            for (;;) { if ((unsigned)__builtin_amdgcn_readfirstlane(__hip_atomic_load(cw, __ATOMIC_RELAXED, __HIP_MEMORY_SCOPE_AGENT)) >= 16u) break;
                if (++sp > (1u << 22)) { dead = true; break; } __builtin_amdgcn_s_sleep(2); }
            __builtin_amdgcn_fence(__ATOMIC_ACQUIRE, "agent");
            if (lane == 0) flag[0] = dead ? 1u : 0u;
        }
        asm volatile("s_waitcnt vmcnt(0) lgkmcnt(0)" ::: "memory"); __builtin_amdgcn_s_barrier(); asm volatile("" ::: "memory");
        const bool bad = flag[0] != 0u;
        if (tid < 256) { float t4 = 0.f;
#pragma unroll
            for (int t = 0; t < 4; ++t) t4 += __hip_atomic_load(slot + tid * 4 + t, __ATOMIC_RELAXED, __HIP_MEMORY_SCOPE_AGENT);
            S[tid] = bad ? __builtin_nanf("") : 1.0f / sqrtf(t4 * (1.0f / DM) + EPS); }
        asm volatile("s_waitcnt vmcnt(0) lgkmcnt(0)" ::: "memory"); __builtin_amdgcn_s_barrier(); asm volatile("" ::: "memory");
        {   f32x4 fgv[2][2];
#pragma unroll
            for (int bj = 0; bj < 2; ++bj)
#pragma unroll
                for (int n = 0; n < 2; ++n) fgv[bj][n] = *(const f32x4*)(fg + EPI_COL(bj) + 4 * n);
#pragma unroll
            for (int ai = 0; ai < 2; ++ai)
#pragma unroll
                for (int m = 0; m < 4; ++m) { const int rl = ai * HALF + wr * 64 + m * 16 + fr; const float rs = S[rl]; const size_t lat = (size_t)(EPI_ROW(ai, m) - CTXL * (bt + 1));
#pragma unroll
                    for (int bj = 0; bj < 2; ++bj) { const size_t off = lat * DM + EPI_COL(bj);
                        *(f32x4*)(out + off) = acc[ai][bj][m][0] * rs * fgv[bj][0]; *(f32x4*)(out + off + 4) = acc[ai][bj][m][1] * rs * fgv[bj][1]; } }
        }
        asm volatile("s_waitcnt lgkmcnt(0)" ::: "memory"); __builtin_amdgcn_s_barrier(); asm volatile("" ::: "memory");
    }
};
}

namespace att {
using bf16 = __hip_bfloat16;
constexpr int NW = 8, QBLK = 32, KVBLK = 64;
constexpr float SCALE = 0.10206207261596575f;
constexpr float THR = 8.f;
constexpr int LDQ = QW, LDK = QKD, LDV = 64, LDO = VW;
constexpr int NSLOT = 3, KSLOT = 12288, VSLOT = 8192;
constexpr int LDS_K = 0, LDS_V = NSLOT * KSLOT, LDS_WS = LDS_V + NSLOT * VSLOT, SHM_ATTN = LDS_WS + NW * 64 * 4;
#define SBAR() __builtin_amdgcn_sched_barrier(0)
__device__ __forceinline__ int crow(int r, int hi) { return (r & 3) + 8 * (r >> 2) + 4 * hi; }
__device__ __forceinline__ unsigned cvtpk(float lo, float hi) { unsigned r; asm volatile("v_cvt_pk_bf16_f32 %0, %1, %2" : "=v"(r) : "v"(lo), "v"(hi)); return r; }
__device__ __forceinline__ bf16x8 ld8(const bf16* p) { return *reinterpret_cast<const bf16x8*>(p); }
__device__ __forceinline__ void glds16(const void* gsrc, unsigned lds_dst) { unsigned keep;
  asm volatile("s_mov_b32 %0, m0\n\ts_mov_b32 m0, %2\n\ts_nop 0\n\tglobal_load_lds_dwordx4 %1, off\n\ts_mov_b32 m0, %0" : "=&s"(keep) : "v"(gsrc), "s"(lds_dst) : "memory"); }

__device__ __forceinline__ void glds16s(unsigned voff, const void* sbase, unsigned lds_dst) { unsigned keep;
  asm volatile("s_mov_b32 %0, m0\n\ts_mov_b32 m0, %3\n\ts_nop 0\n\tglobal_load_lds_dwordx4 %1, %2\n\ts_mov_b32 m0, %0" : "=&s"(keep) : "v"(voff), "s"(sbase), "s"(lds_dst) : "memory"); }
__device__ __forceinline__ float rowmax32(const f32x16& p0, const f32x16& p1) {
  float pmax = p0[0];
#pragma unroll
  for (int r = 1; r < 16; ++r) pmax = fmaxf(pmax, p0[r]);
#pragma unroll
  for (int r = 0; r < 16; ++r) pmax = fmaxf(pmax, p1[r]);
  auto rr = __builtin_amdgcn_permlane32_swap(__float_as_uint(pmax), __float_as_uint(pmax), false, false);
  return fmaxf(__uint_as_float(rr[0]), __uint_as_float(rr[1]));
}
constexpr float THR2 = THR * 1.4426950408889634f;
__device__ __forceinline__ void decide(const f32x16& p0, const f32x16& p1, float& mhat, f32x16& negm, float& alpha) {
  const float pmax = rowmax32(p0, p1);
  if (__builtin_expect(__all(pmax <= THR2), 1)) { alpha = 1.f; }
  else { const float dl = fmaxf(pmax, 0.f); mhat += dl;
#pragma unroll
    for (int r = 0; r < 16; ++r) negm[r] = -mhat;
    alpha = __builtin_amdgcn_exp2f(-dl); }
}
__device__ __forceinline__ void guard(float ps, float& mhat, f32x16& negm, float& alpha) {
  constexpr float BIG = 1073741824.f;
  if (__builtin_expect(__all(ps <= BIG), 1)) { alpha = 1.f; }
  else { mhat += 30.f;
#pragma unroll
    for (int r = 0; r < 16; ++r) negm[r] = -mhat;
    alpha = 9.313225746154785e-10f; }
}
__device__ __forceinline__ void exps32(f32x16& p0, f32x16& p1) {
#pragma unroll
  for (int r = 0; r < 16; ++r) p0[r] = __builtin_amdgcn_exp2f(p0[r]);
#pragma unroll
  for (int r = 0; r < 16; ++r) p1[r] = __builtin_amdgcn_exp2f(p1[r]);
}
__device__ __forceinline__ void finishP(const f32x16& p0, const f32x16& p1, float alpha, float& l_reg, bf16x8& pa0, bf16x8& pa1, bf16x8& pa2, bf16x8& pa3, float& ps_out) {
  float ps = 0, ps2 = 0;
#pragma unroll
  for (int r = 0; r < 16; ++r) ps += p0[r];
#pragma unroll
  for (int r = 0; r < 16; ++r) ps2 += p1[r];
  ps += ps2;
  l_reg = (l_reg + ps) * alpha; ps_out = ps;
#define PK4(P, BASE, OUT) do { unsigned a0 = cvtpk(P[BASE + 0], P[BASE + 1]), a1 = cvtpk(P[BASE + 2], P[BASE + 3]);   \
    unsigned b0 = cvtpk(P[BASE + 4], P[BASE + 5]), b1 = cvtpk(P[BASE + 6], P[BASE + 7]);                              \
    u32x4 w = {a0, a1, b0, b1}; OUT = *reinterpret_cast<bf16x8*>(&w); } while (0)
  PK4(p0, 0, pa0); PK4(p0, 8, pa1); PK4(p1, 0, pa2); PK4(p1, 8, pa3);
#undef PK4
}
__device__ __forceinline__ void qkt(f32x16& p0, f32x16& p1, const char* Ks, const bf16x8* qr, const f32x16& negm) {
#pragma unroll
  for (int d0 = 0; d0 < 6; ++d0) {
    bf16x8 b0 = *reinterpret_cast<const bf16x8*>(Ks + d0 * 2048);
    bf16x8 b1 = *reinterpret_cast<const bf16x8*>(Ks + d0 * 2048 + 512);
    if (d0 == 0) { p0 = __builtin_amdgcn_mfma_f32_32x32x16_bf16(b0, qr[0], negm, 0, 0, 0); p1 = __builtin_amdgcn_mfma_f32_32x32x16_bf16(b1, qr[0], negm, 0, 0, 0); }
    else { p0 = __builtin_amdgcn_mfma_f32_32x32x16_bf16(b0, qr[d0], p0, 0, 0, 0); p1 = __builtin_amdgcn_mfma_f32_32x32x16_bf16(b1, qr[d0], p1, 0, 0, 0); } }
}
__device__ __forceinline__ int v_rd_base(int lane) { return ((lane & 3) << 3) | (((lane >> 2) & 3) << 6) | (((lane >> 4) & 1) << 5) | (((lane >> 5) & 1) << 8); }
constexpr int v_rd_off(int d0, int ks, int half) { return d0 * 512 + ks * 2048 + half * 1024; }
template <int OFF> __device__ __forceinline__ s16x4 tr_read(int vb) {
  s16x4 r; asm volatile("ds_read_b64_tr_b16 %0, %1 offset:%2" : "=&v"(r) : "v"(vb), "i"(OFF) : "memory"); return r;
}
struct VF { s16x4 l[2][4], h[2][4]; };
__device__ __forceinline__ void v_read(VF& f, int vb) {
#define VR(D0, KS) f.l[D0][KS] = tr_read<v_rd_off(D0, KS, 0)>(vb); f.h[D0][KS] = tr_read<v_rd_off(D0, KS, 1)>(vb);
  VR(0, 0) VR(0, 1) VR(0, 2) VR(0, 3) VR(1, 0) VR(1, 1) VR(1, 2) VR(1, 3)
#undef VR
}
__device__ __forceinline__ void v_wait(VF& f) {
  asm volatile("s_waitcnt lgkmcnt(0)" : "+v"(f.l[0][0]), "+v"(f.l[0][1]), "+v"(f.l[0][2]), "+v"(f.l[0][3]), "+v"(f.h[0][0]), "+v"(f.h[0][1]), "+v"(f.h[0][2]), "+v"(f.h[0][3]),
               "+v"(f.l[1][0]), "+v"(f.l[1][1]), "+v"(f.l[1][2]), "+v"(f.l[1][3]), "+v"(f.h[1][0]), "+v"(f.h[1][1]), "+v"(f.h[1][2]), "+v"(f.h[1][3]) :: "memory");
}
__device__ __forceinline__ void pv_mma(f32x16* o, const VF& f, bf16x8 pa0, bf16x8 pa1, bf16x8 pa2, bf16x8 pa3) {
#define PK(L, H) (bf16x8){L[0], L[1], L[2], L[3], H[0], H[1], H[2], H[3]}
#pragma unroll
  for (int d = 0; d < 2; ++d) {
    o[d] = __builtin_amdgcn_mfma_f32_32x32x16_bf16(pa0, PK(f.l[d][0], f.h[d][0]), o[d], 0, 0, 0);
    o[d] = __builtin_amdgcn_mfma_f32_32x32x16_bf16(pa1, PK(f.l[d][1], f.h[d][1]), o[d], 0, 0, 0);
    o[d] = __builtin_amdgcn_mfma_f32_32x32x16_bf16(pa2, PK(f.l[d][2], f.h[d][2]), o[d], 0, 0, 0);
    o[d] = __builtin_amdgcn_mfma_f32_32x32x16_bf16(pa3, PK(f.l[d][3], f.h[d][3]), o[d], 0, 0, 0); }
#undef PK
}

__device__ __forceinline__ void attn_unit(const bf16* __restrict__ Qb, const bf16* __restrict__ Kh, const bf16* __restrict__ Vh, bf16* __restrict__ Ob, int seq, char* lds, const float* __restrict__ tab, int t0) {
  int tid_ = threadIdx.x; asm volatile("" : "+v"(tid_));
  const int tid = tid_, lane = tid & 63, r32 = lane & 31, hi = lane >> 5; const int wid = __builtin_amdgcn_readfirstlane(tid >> 6);
  const unsigned lds0 = (unsigned)(uintptr_t)lds;
  float* ws = (float*)(lds + LDS_WS) + wid * 64; float* li_l = ws; float* al_l = ws + 32;
  float mhat = 0.f, l_reg = 0; f32x16 o[2] = {}; bf16x8 qr[6]; f32x16 negm = f32x16{}; asm volatile("" : "+v"(negm));
  const bf16* Qw = Qb + (long)(wid * QBLK + r32) * LDQ + hi * 8;
#pragma unroll
  for (int d0 = 0; d0 < 6; ++d0) qr[d0] = ld8(Qw + d0 * 16);
  { const int tq = t0 + wid * QBLK + r32;
#pragma unroll
    for (int part = 0; part < 2; ++part) { const int pos = part ? (tq & 63) : (tq >> 6); const float* tp = tab + pos * 16 + hi * 8;
      const f32x4 c0 = *(const f32x4*)tp, c1 = *(const f32x4*)(tp + 4);
      const f32x4 cs = (f32x4){c0[0], c0[2], c1[0], c1[2]}, sn = (f32x4){c0[1], c0[3], c1[1], c1[3]};
      const u32x4 w = __builtin_bit_cast(u32x4, qr[4 + part]); f32x4 x1, x2; unpack8(w, x1, x2);
      qr[4 + part] = __builtin_bit_cast(bf16x8, pack8(x1 * cs - x2 * sn, x1 * sn + x2 * cs)); } }
  const bool k2 = wid < 4;
  const unsigned koffA = (unsigned)(wid * 512 + lane * 8) * 2u, koffB = (unsigned)((8 + (wid & 3)) * 512 + lane * 8) * 2u;
  const int vkk = wid * 8 + ((lane >> 2) & 7), vkey = vkk;
  const unsigned voffV = (unsigned)(vkey * LDV + (lane >> 5) * 32 + (lane & 3) * 8) * 2u;
  const unsigned kdstA = lds0 + LDS_K + wid * 1024, kdstB = lds0 + LDS_K + (8 + (wid & 3)) * 1024, vdst = lds0 + LDS_V + wid * 1024;
#define DMA_K(t, slot) do { const bf16* kb_ = Kh + (long)(t) * KVBLK * LDK; glds16s(koffA, kb_, (unsigned)__builtin_amdgcn_readfirstlane(kdstA + (slot) * KSLOT)); \
    if (k2) glds16s(koffB, kb_, (unsigned)__builtin_amdgcn_readfirstlane(kdstB + (slot) * KSLOT)); } while (0)
#define DMA_V(t, slot) glds16s(voffV, Vh + (long)(t) * KVBLK * LDV, (unsigned)__builtin_amdgcn_readfirstlane(vdst + (slot) * VSLOT))
#define WAIT_ALL_BAR() asm volatile("s_waitcnt vmcnt(0) lgkmcnt(0)\n\ts_barrier" ::: "memory")
#define WAIT_STEP_BAR() do { if (k2) asm volatile("s_waitcnt vmcnt(3) lgkmcnt(0)\n\ts_barrier" ::: "memory"); else asm volatile("s_waitcnt vmcnt(2) lgkmcnt(0)\n\ts_barrier" ::: "memory"); } while (0)
#define RESC(a) do { if (__any((a) < 1.f)) { \
    _Pragma("unroll") for (int d = 0; d < 2; ++d) _Pragma("unroll") for (int r = 0; r < 16; ++r) o[d][r] *= (a); } } while (0)
  const char* kp0 = lds + LDS_K + hi * 1024 + r32 * 16;
  const int vb0 = (int)(lds0 + LDS_V) + v_rd_base(lane);
  f32x16 pA0, pA1, pB0, pB1; float alA, alB, psum; bf16x8 pa0, pa1, pa2, pa3; VF vf; const int NT = seq / KVBLK;
  int s_prev = 2, s_cur = 0, s_next = 1;
#define ROT() do { const int t_ = s_prev; s_prev = s_cur; s_cur = s_next; s_next = t_; } while (0)
#define STEP(N0, N1, O0, O1, alN, alO, t) do { \
    const bool full_ = (t) + 2 < NT; \
    qkt(N0, N1, kp0 + s_cur * KSLOT, qr, negm); \
    finishP(O0, O1, alO, l_reg, pa0, pa1, pa2, pa3, psum); \
    _Pragma("unroll") for (int g_ = 0; g_ < 12; ++g_) { __builtin_amdgcn_sched_group_barrier(0x008, 1, 0); __builtin_amdgcn_sched_group_barrier(0x002, 5, 0); } \
    v_read(vf, vb0 + s_prev * VSLOT);     \
    if (full_) DMA_K((t) + 2, s_prev); if ((t) + 1 < NT) DMA_V((t) + 1, s_next);     \
    guard(psum, mhat, negm, alN); v_wait(vf); \
    pv_mma(o, vf, pa0, pa1, pa2, pa3); exps32(N0, N1); asm volatile("" : "+v"(N0), "+v"(N1)); \
    _Pragma("unroll") for (int g_ = 0; g_ < 8; ++g_) { __builtin_amdgcn_sched_group_barrier(0x008, 1, 0); __builtin_amdgcn_sched_group_barrier(0x002, 4, 0); } \
    RESC(alO); \
    if (full_) WAIT_STEP_BAR(); else WAIT_ALL_BAR(); \
    ROT(); } while (0)
  DMA_K(0, 0); DMA_V(0, 0); DMA_K(1, 1);
  WAIT_ALL_BAR();
  DMA_K(2, 2); DMA_V(1, 1);
  qkt(pA0, pA1, kp0, qr, negm);
  { const float dl = rowmax32(pA0, pA1); mhat = dl;
#pragma unroll
    for (int r = 0; r < 16; ++r) { pA0[r] -= dl; pA1[r] -= dl; }
#pragma unroll
    for (int r = 0; r < 16; ++r) negm[r] = -mhat;
    asm volatile("" : "+v"(negm)); alA = 1.f; }
  exps32(pA0, pA1); asm volatile("" : "+v"(pA0), "+v"(pA1));
  WAIT_ALL_BAR(); ROT();
  int t = 1;
  for (; t + 1 < NT; t += 2) {
    STEP(pB0, pB1, pA0, pA1, alB, alA, t);
    STEP(pA0, pA1, pB0, pB1, alA, alB, t + 1);
  }
  STEP(pB0, pB1, pA0, pA1, alB, alA, t);
  v_read(vf, vb0 + s_prev * VSLOT);
  finishP(pB0, pB1, 1.f, l_reg, pa0, pa1, pa2, pa3, psum); v_wait(vf);
  pv_mma(o, vf, pa0, pa1, pa2, pa3);
  { auto rr = __builtin_amdgcn_permlane32_swap(__float_as_uint(l_reg), __float_as_uint(l_reg), false, false); l_reg = __uint_as_float(rr[0]) + __uint_as_float(rr[1]); }
  if (hi == 0) li_l[r32] = l_reg; asm volatile("s_waitcnt lgkmcnt(0)" ::: "memory");
  float rli[16];
#pragma unroll
  for (int r = 0; r < 16; ++r) rli[r] = __builtin_amdgcn_rcpf(li_l[crow(r, hi)]);
  bf16* Ow = Ob + (long)(wid * QBLK) * LDO;
#pragma unroll
  for (int r = 0; r < 16; ++r) { int orow = crow(r, hi);
#pragma unroll
    for (int d0 = 0; d0 < 2; ++d0) Ow[(long)orow * LDO + d0 * 32 + r32] = __float2bfloat16(o[d0][r] * rli[r]); }
  asm volatile("s_waitcnt vmcnt(0) lgkmcnt(0)\n\ts_barrier" ::: "memory");
#undef DMA_K
#undef DMA_V
#undef WAIT_ALL_BAR
#undef WAIT_STEP_BAR
#undef RESC
#undef ROT
#undef STEP
}
#undef SBAR
}


#define XB_TMO      128
#define XB_XCNT(j)  (256  + 64 * (j))
#define XB_XSUB(j)  (1280 + 64 * (j))
#define XB_XGEN(j)  (2304 + 64 * (j))
#define XB_TOP      3328
#define XB_TOPGEN   3392
#define XCD_BAR_WORDS 3456
#define XB_SPIN_CAP (1u << 22)
__device__ __forceinline__ unsigned xb_ld(unsigned* p)              { return __hip_atomic_load(p, __ATOMIC_RELAXED, __HIP_MEMORY_SCOPE_AGENT); }
__device__ __forceinline__ unsigned xb_add(unsigned* p, unsigned v) { return __hip_atomic_fetch_add(p, v, __ATOMIC_RELAXED, __HIP_MEMORY_SCOPE_AGENT); }
__device__ __forceinline__ unsigned xb_xcc_id() { return (unsigned)__builtin_amdgcn_s_getreg((3 << 11) | 20) & 0xFu; }
#define XB_SPIN(cond, bar) do { unsigned _sp = 0; while (cond) { __builtin_amdgcn_s_sleep(1); \
    if ((++_sp & 255u) == 0u) { if (xb_ld(&(bar)[XB_TMO])) break; if (_sp > XB_SPIN_CAP) { atomicAdd(&(bar)[XB_TMO], 1u); break; } } } } while (0)
struct XcdBarrier { unsigned* bar; unsigned x; volatile LAS unsigned* st; };
__device__ __forceinline__ XcdBarrier xcd_barrier_post(unsigned* bar, volatile LAS unsigned* st) {
    XcdBarrier b; b.bar = bar; b.x = xb_xcc_id(); b.st = st;
    if (threadIdx.x == 0) (void)xb_add(&bar[XB_XCNT(b.x)], 1u);
    return b;
}
__device__ __forceinline__ void xcd_barrier_complete(unsigned* bar, unsigned x, unsigned& nloc, unsigned& nx) {
    const unsigned G = gridDim.x * gridDim.y * gridDim.z;
    unsigned sum, cnt, mine, sp = 0u;
    for (;;) {
        sum = 0u; cnt = 0u; mine = 0u;
#pragma unroll
        for (unsigned j = 0; j < 16; ++j) { const unsigned c = xb_ld(&bar[XB_XCNT(j)]); sum += c; cnt += (c > 0u) ? 1u : 0u; mine = (j == x) ? c : mine; }
        if (sum == G) break;
        __builtin_amdgcn_s_sleep(1);
        if ((++sp & 255u) == 0u) { if (xb_ld(&bar[XB_TMO])) break; if (sp > XB_SPIN_CAP) { atomicAdd(&bar[XB_TMO], 1u); break; } }
    }
    nloc = mine > 0u ? mine : 1u; nx = cnt > 0u ? cnt : 1u;
}
__device__ __forceinline__ void xcd_barrier(const XcdBarrier& b) {
    asm volatile("s_waitcnt vmcnt(0)" ::: "memory");
    __syncthreads();
    if (threadIdx.x == 0) {
        unsigned* bar = b.bar;
        __builtin_amdgcn_s_waitcnt(0);
        unsigned nloc = b.st[0], nx = b.st[1];
        if (nloc == 0u) { xcd_barrier_complete(bar, b.x, nloc, nx); b.st[0] = nloc; b.st[1] = nx; }
        const unsigned old = xb_add(&bar[XB_XSUB(b.x)], 1u);
        const unsigned gen = old / nloc;
        if (old + 1u == (gen + 1u) * nloc) {
            __builtin_amdgcn_fence(__ATOMIC_RELEASE, "agent");
            asm volatile("s_waitcnt vmcnt(0)" ::: "memory");
            const unsigned og = xb_add(&bar[XB_TOP], 1u);
            const unsigned tg = og / nx;
            if (og + 1u == (tg + 1u) * nx) xb_add(&bar[XB_TOPGEN], 1u);
            else XB_SPIN(xb_ld(&bar[XB_TOPGEN]) == tg, bar);
            __builtin_amdgcn_fence(__ATOMIC_ACQUIRE, "agent");
            xb_add(&bar[XB_XGEN(b.x)], 1u);
            asm volatile("s_waitcnt vmcnt(0)" ::: "memory");
        } else {
            XB_SPIN(xb_ld(&bar[XB_XGEN(b.x)]) == gen, bar);
            __builtin_amdgcn_fence(__ATOMIC_ACQUIRE, "agent");
            asm volatile("s_waitcnt vmcnt(0)" ::: "memory");
        }
    }
    __syncthreads();
}

template <class RowMap>
__device__ __forceinline__ void transpose_item(const float* W, int K, int N, bf16_t* WT, LAS float* scr, int item, int lane, const float* kscale, RowMap rm) {
    const int nblk = N / 32, kb = item / nblk, nb = item % nblk, k0 = 64 * kb, n0 = 32 * nb;
#pragma unroll 8
    for (int i = 0; i < 32; ++i) { const int kk = 2 * i + (lane >> 5); float v = W[(size_t)(k0 + kk) * N + n0 + (lane & 31)]; if (kscale) v *= kscale[k0 + kk]; scr[kk * 33 + (lane & 31)] = v; }
    asm volatile("s_waitcnt lgkmcnt(0)" ::: "memory");
    const int c = lane & 7;
#pragma unroll
    for (int j = 0; j < 4; ++j) { const int n = (lane >> 3) + 8 * j; const LAS float* s = scr + (8 * c) * 33 + n;
        u32x4 o; o.x = cvt_pk_bf16(s[0 * 33], s[1 * 33]); o.y = cvt_pk_bf16(s[2 * 33], s[3 * 33]); o.z = cvt_pk_bf16(s[4 * 33], s[5 * 33]); o.w = cvt_pk_bf16(s[6 * 33], s[7 * 33]);
        *(u32x4*)(WT + (size_t)rm(n0 + n) * K + k0 + 8 * c) = o; }
    asm volatile("s_waitcnt lgkmcnt(0)" ::: "memory");
}
template <int NR>
__device__ __forceinline__ void gemv_item(const float* W, int N, const LAS float* sv, float* dst, const float* bias, int cgp, int ks, int lane) {
    const int col = cgp * 256 + lane * 4; f32x4 acc[NR];
#pragma unroll
    for (int b = 0; b < NR; ++b) acc[b] = (f32x4){0.f, 0.f, 0.f, 0.f};
    const float* wp = W + (size_t)(ks * 128) * N + col;
#pragma unroll 8
    for (int k = 0; k < 128; ++k) { const f32x4 w = *(const f32x4*)(wp + (size_t)k * N);
#pragma unroll
        for (int b = 0; b < NR; ++b) acc[b] += w * sv[b * 1024 + ks * 128 + k]; }
#pragma unroll
    for (int b = 0; b < NR; ++b) { if (bias && ks == 0) acc[b] += *(const f32x4*)(bias + col);
#pragma unroll
        for (int i = 0; i < 4; ++i) unsafeAtomicAdd(dst + (size_t)b * N + col + i, acc[b][i]); }
}

__global__ void __launch_bounds__(512, 2) fwd(Args a) {
    extern __shared__ __attribute__((aligned(16))) unsigned char lds_raw[];
    LAS unsigned char* lds = (LAS unsigned char*)lds_raw;
    const int tid = threadIdx.x, lane = tid & 63, wave = __builtin_amdgcn_readfirstlane(tid >> 6);
    const int G = gridDim.x, bx = blockIdx.x, gw = bx * 8 + wave, NGW = G * 8;
    unsigned char* ws = a.ws;
    float* mod = (float*)(ws + WS_MOD); float* bias2 = (float*)(ws + WS_BIAS2);
    float* ssq_q = (float*)(ws + WS_SSQQ); float* ssq_kv = (float*)(ws + WS_SSQKV); float* ssq2 = (float*)(ws + WS_SSQ2); float* ssq3 = (float*)(ws + WS_SSQ3);
    float* tab = (float*)(ws + WS_TAB);
    bf16_t* WinT = (bf16_t*)(ws + WS_WIN); bf16_t* WuqT = (bf16_t*)(ws + WS_WUQ); bf16_t* WukvT = (bf16_t*)(ws + WS_WUKV); bf16_t* WbmT = (bf16_t*)(ws + WS_WBM);
    bf16_t* WppT = (bf16_t*)(ws + WS_WPP); bf16_t* WoutT = (bf16_t*)(ws + WS_WOUT); bf16_t* W1T = (bf16_t*)(ws + WS_W1); bf16_t* W2T = (bf16_t*)(ws + WS_W2);
    bf16_t* Hb = (bf16_t*)(ws + WS_H); bf16_t* Qb = (bf16_t*)(ws + WS_Q); bf16_t* Kb = (bf16_t*)(ws + WS_K); bf16_t* Vb = (bf16_t*)(ws + WS_V); bf16_t* Mg = (bf16_t*)(ws + WS_MERGED);
    bf16_t* Dp = (bf16_t*)(ws + WS_DPOOL); bf16_t* At = (bf16_t*)(ws + WS_ATTN); bf16_t* X1s = (bf16_t*)(ws + WS_X1S);
    bf16_t* X1b = (bf16_t*)(ws + WS_R1 + 132 * MiB);
    unsigned char* G8b = ws + WS_G8;
    bf16_t* Yb = (bf16_t*)(ws + WS_Y); bf16_t* Ub = (bf16_t*)(ws + WS_U);
    const int lo = a.ph_lo, hi_ph = a.ph_hi;
#if MK_COOP
    volatile LAS unsigned* bst = (volatile LAS unsigned*)(lds + LDS_BYTES - 64);
    if (tid < 16) bst[tid] = 0u;
    __syncthreads();
    XcdBarrier bar = xcd_barrier_post((unsigned*)(ws + WS_BAR), bst);
    if (lo < 0) cg::this_grid().sync();
#endif
#ifndef PHMASK
#define PHMASK 0x1ff
#endif
#define IN(k) (((PHMASK >> (k)) & 1) && lo <= (k) && (k) < hi_ph)
#if MK_COOP
#define SEAM(k) do { if (IN(k) && IN((k) + 1)) xcd_barrier(bar); } while (0)
#else
#define SEAM(k) do { } while (0)
#endif

    if (IN(0)) {
        LAS float* sil = (LAS float*)(lds + 73728);
        for (int i = tid; i < 9 * 1024; i += 512) { const int b = i >> 10, k = i & 1023; const float v = (b < 8) ? a.in[1][b * 1024 + k] : a.in[3][k]; sil[i] = v / (1.f + __expf(-v)); }
        __syncthreads();
        LAS float* scr = (LAS float*)(lds + wave * 8448);
        constexpr int I_ADA = 24 * 8, I_PP = 1024, I_IN = 16 * 101, I_UQ = 6 * 24, I_UKV = 4 * 32, I_BM = 8 * 32, I_OUT = 16 * 32, I_W1 = 16 * 128, I_W2 = 64 * 32, I_PAD = 96, I_TAB = 1;
        constexpr int NITEMS = I_ADA + I_PP + I_IN + I_UQ + I_UKV + I_BM + I_OUT + I_W1 + I_W2 + I_PAD + I_TAB;
        auto ident = [](int n) { return n; };
        for (int it = gw; it < NITEMS; it += NGW) {
            int r = it;
            if (r < I_ADA) { gemv_item<9>(a.in[4], 6144, sil, mod, a.in[5], r >> 3, r & 7, lane); continue; } r -= I_ADA;
            if (r < I_PP) {
                const int kc = r >> 4, nb = r & 15, k0 = kc * 8, gI = k0 >> 7, c0 = k0 & 127, n = nb * 64 + lane;
                const float* pw = a.in[13] + (size_t)(gI * 128 + c0) * 128; const float* psc = a.in[14] + gI * 128; const float* wb = a.in[15] + (size_t)(gI * 128) * 1024 + n;
                float ac[8] = {0.f, 0.f, 0.f, 0.f, 0.f, 0.f, 0.f, 0.f};
#pragma unroll 4
                for (int d = 0; d < 128; ++d) { const float wv = wb[(size_t)d * 1024] * psc[d];
#pragma unroll
                    for (int i = 0; i < 8; ++i) ac[i] += pw[i * 128 + d] * wv; }
                u32x4 o; o.x = cvt_pk_bf16(ac[0], ac[1]); o.y = cvt_pk_bf16(ac[2], ac[3]); o.z = cvt_pk_bf16(ac[4], ac[5]); o.w = cvt_pk_bf16(ac[6], ac[7]);
                *(u32x4*)(WppT + (size_t)n * 512 + k0) = o; continue; } r -= I_PP;
            if (r < I_IN) { transpose_item(a.in[7], 1024, 3232, WinT, scr, r, lane, nullptr, [](int n) { return n < 384 ? n : (n < 640 ? n + 128 : (n < 672 ? n - 256 : n + 96)); }); continue; } r -= I_IN;
            if (r < I_UQ) { transpose_item(a.in[10], 384, 768, WuqT, scr, r, lane, a.in[8], [](int n) { const int d = n % 96; if (d < 64) return n; const int p = d - 64, part = p >> 4, half = (p >> 3) & 1, j = p & 7;
                                return n - d + 64 + 8 * (part * 2 + (j >> 2)) + 4 * half + (j & 3); }); continue; } r -= I_UQ;
            if (r < I_UKV) { transpose_item(a.in[11], 256, 1024, WukvT, scr, r, lane, a.in[9], [](int n) { const int h = n >> 7, e = n & 127; return e < 64 ? h * 64 + e : 512 + h * 64 + (e - 64); }); continue; } r -= I_UKV;
            if (r < I_BM) { transpose_item(a.in[12], 512, 1024, WbmT, scr, r, lane, nullptr, ident); continue; } r -= I_BM;
            if (r < I_OUT) { transpose_item(a.in[16], 1024, 1024, WoutT, scr, r, lane, nullptr, ident); continue; } r -= I_OUT;
            if (r < I_W1) { transpose_item(a.in[18], 1024, 4096, W1T, scr, r, lane, nullptr, ident); continue; } r -= I_W1;
            if (r < I_W2) { transpose_item(a.in[19], 4096, 1024, W2T, scr, r, lane, nullptr, ident); continue; } r -= I_W2;
            if (r < I_PAD) { u32x4 z = {0u, 0u, 0u, 0u}; u32x4* p = (u32x4*)(WinT + (size_t)(416 + r) * 1024); p[lane] = z; p[64 + lane] = z; continue; } r -= I_PAD;
            {
                for (int e = lane; e < 1024; e += 64) { const int pos = e >> 3, j = e & 7; const float invf = powf(10000.0f, -(float)(2 * j) / 16.0f); const float ang = (float)pos * invf;
                    tab[2 * e] = cosf(ang); tab[2 * e + 1] = sinf(ang); } }
        }
    }
    SEAM(0);

    if (IN(1)) {
        LAS float* sh2 = (LAS float*)(lds + 73728);
        for (int i = tid; i < 8 * 1024; i += 512) sh2[i] = mod[(i >> 10) * 6144 + 3072 + (i & 1023)];
        __syncthreads();
        if (gw < 128) gemv_item<8>(a.in[18], 4096, sh2, bias2, nullptr, gw >> 3, gw & 7, lane);
        const float* g1 = a.in[6];
        for (int r = gw; r < MEXT; r += NGW) {
            const int b = r / EXT, j = r - b * EXT; const bool isctx = j < CTXL;
            const float* src = isctx ? a.in[2] + (size_t)(b * CTXL + j) * DM : a.in[0] + (size_t)(b * SEQ + j - CTXL) * DM; const float* mb = mod + (isctx ? 8 : b) * 6144;
            f32x4 v[4]; float s = 0.f;
#pragma unroll
            for (int q = 0; q < 4; ++q) { v[q] = *(const f32x4*)(src + 4 * lane + 256 * q); s += (v[q][0] * v[q][0] + v[q][1] * v[q][1]) + (v[q][2] * v[q][2] + v[q][3] * v[q][3]); }
            const float rstd = 1.0f / sqrtf(wave_sum(s) * (1.0f / DM) + EPS);
#pragma unroll
            for (int q = 0; q < 4; ++q) { const int col = 4 * lane + 256 * q; const f32x4 g = *(const f32x4*)(g1 + col), sc = *(const f32x4*)(mb + 1024 + col), sh = *(const f32x4*)(mb + col);
                const f32x4 o = v[q] * rstd * g * (sc + 1.0f) + sh; u32x2 w; w.x = cvt_pk_bf16(o[0], o[1]); w.y = cvt_pk_bf16(o[2], o[3]);
                *(u32x2*)(Hb + (size_t)r * DM + col) = w; }
        }
    }
    SEAM(1);

    if (IN(2)) {
        pg8::Gemm g{Hb, WinT, DM, DM}; pg8::Order S; S.init(MEXT / 256, NWIN / 256, G, bx, 0);
        pg8::EpiY E{Yb, G8b, ssq_q, ssq_kv};
        pg8::gemm_phase(lds, g, S, E);
    }
    SEAM(2);

    if (IN(3)) {
#ifndef NO_P3A
        { pg8::Gemm g{Yb + Y_CQ, WuqT, YW, 384}; pg8::Order S; S.init(MLAT / 256, QW / 256, G, bx, 1);
          pg8::EpiQ E{Qb, ssq_q}; pg8::gemm_phase(lds, g, S, E); }
#endif
#ifndef NO_P3B
        { pg8::Gemm g{Yb + Y_CKV, WukvT, YW, 256}; pg8::Order S; S.init(MEXT / 256, 1024 / 256, G, bx, 0);
          pg8::EpiKV E{Kb, ssq_kv}; pg8::gemm_phase(lds, g, S, E); }
#endif
        const int gt = bx * 512 + tid, NTH = G * 512;
#ifndef NO_P3C
        for (int idx = gt; idx < MEXT * 4; idx += NTH) {
            const int r = idx >> 2, fq = idx & 3, b = r / EXT, j = r - b * EXT, part = fq >> 1, j0 = 4 * (fq & 1);
            const bf16_t* src = Yb + (size_t)r * YW + Y_KR + part * 16 + j0;
            const u32x2 a1 = *(const u32x2*)src, a2 = *(const u32x2*)(src + 8);
            f32x4 x1 = (f32x4){bf_lo(a1.x), bf_hi(a1.x), bf_lo(a1.y), bf_hi(a1.y)}, x2 = (f32x4){bf_lo(a2.x), bf_hi(a2.x), bf_lo(a2.y), bf_hi(a2.y)};
            if (j >= CTXL) { const int t = j - CTXL, pos = part ? (t & 63) : (t >> 6); const float* tp = tab + pos * 16 + j0 * 2;
                const f32x4 t0 = *(const f32x4*)tp, t1 = *(const f32x4*)(tp + 4);
                const f32x4 cs = (f32x4){t0[0], t0[2], t1[0], t1[2]}, sn = (f32x4){t0[1], t0[3], t1[1], t1[3]};
                const f32x4 o1 = x1 * cs - x2 * sn, o2 = x1 * sn + x2 * cs; x1 = o1; x2 = o2; }
            const u32x4 w = pack8(x1, x2);
#pragma unroll
            for (int h = 0; h < NH; ++h) *(u32x4*)(Kb + ((size_t)((b * NH + h) * (EXT / 64) + (j >> 6)) * 12 + 8 + fq) * 512 + (size_t)(j & 63) * 8) = w;
        }
#endif
#ifndef NO_P3D
        for (int idx = gt; idx < (MLAT / 32) * 64; idx += NTH) {
            const int seg = idx >> 6, ch = idx & 63, b = seg >> 8, t0 = (seg & 255) << 5, half = 1 << (ch >> 4);
            const bf16_t* base = Yb + (size_t)(b * EXT + CTXL) * YW + Y_POOL + ch * 8;
            bf16_t* dst = Dp + (size_t)(b * EXT + CTXL) * 512 + ch * 8;
            f32x4 s0 = (f32x4){0.f, 0.f, 0.f, 0.f}, s1 = s0;
            for (int sidx = max(t0 - half, 0); sidx < min(t0 + half, SEQ); ++sidx) { f32x4 p0, p1; unpack8(*(const u32x4*)(base + (size_t)sidx * YW), p0, p1); s0 += p0; s1 += p1; }
#pragma unroll 4
            for (int t = t0; t < t0 + 32; ++t) {
                const int cnt = min(t + half, SEQ) - max(t - half, 0); const float inv = 1.0f / (float)cnt;
                f32x4 c0, c1; unpack8(*(const u32x4*)(base + (size_t)t * YW), c0, c1);
                *(u32x4*)(dst + (size_t)t * 512) = pack8(s0 * inv - c0, s1 * inv - c1);
                if (t + half < SEQ) { f32x4 p0, p1; unpack8(*(const u32x4*)(base + (size_t)(t + half) * YW), p0, p1); s0 += p0; s1 += p1; }
                if (t - half >= 0) { f32x4 p0, p1; unpack8(*(const u32x4*)(base + (size_t)(t - half) * YW), p0, p1); s0 -= p0; s1 -= p1; }
            }
        }
#endif
    }
    SEAM(3);

    if (IN(4)) {
        const int xcd = bx & 7, loc = bx >> 3, per = G >> 3;
        for (int rep = 0; rep < REP4; ++rep)
        for (int i = 0; i < 8; ++i) {
            const int bh = xcd * 8 + i, b = bh >> 3, h = bh & 7;
            for (int qb = loc; qb < 32; qb += per) {
                const size_t krow0 = (size_t)b * EXT, qrow0 = krow0 + CTXL + (size_t)qb * 256;
                att::attn_unit((const att::bf16*)(Qb + qrow0 * QW + h * QKD), (const att::bf16*)(Kb + (size_t)bh * EXT * QKD), (const att::bf16*)(Vb + (size_t)bh * EXT * 64),
                               (att::bf16*)(At + qrow0 * VW + h * 64), EXT, (char*)lds_raw, tab, qb * 256);
            }
        }
    }
    SEAM(4);

    if (IN(5)) {
        { pg8::Gemm g{At, WbmT, 512, 512}; pg8::Order S; S.init(MLAT / 256, 4, G, bx, 1); pg8::EpiMerge<0> E{Mg, G8b}; pg8::gemm_phase(lds, g, S, E); }
        { pg8::Gemm g{Dp, WppT, 512, 512}; pg8::Order S; S.init(MLAT / 256, 4, G, bx, 1); pg8::EpiMerge<1> E{Mg, G8b}; pg8::gemm_phase(lds, g, S, E); }
    }
    SEAM(5);

    if (IN(6)) {
        pg8::Gemm g{Mg, WoutT, DM, DM}; pg8::Order S; S.init(MLAT / 256, 4, G, bx, 1);
        pg8::EpiOut E{a.in[0], X1b, X1s, mod, a.in[17], ssq2}; pg8::gemm_phase(lds, g, S, E);
    }
    SEAM(6);

    if (IN(7)) {
        pg8::Gemm g{X1s, W1T, DM, DM}; pg8::Order S; S.init(MLAT / 256, DFF / 256, G, bx, 1);
        pg8::EpiUp E{Ub, ssq2, bias2}; for (int rep = 0; rep < REP7; ++rep) pg8::gemm_phase(lds, g, S, E);
    }
    SEAM(7);

    if (IN(8)) {
        pg8::Gemm g{Ub, W2T, DFF, DFF}; pg8::Order S; S.init(MLAT / 256, 4, G, bx, 1);
        pg8::EpiDown E{a.out, X1b, mod, a.in[20], (float*)(ws + WS_XBUF), (unsigned*)(ws + WS_XCNT), lds + 131072}; pg8::gemm_phase(lds, g, S, E);
    }
#undef IN
#undef SEAM
}

extern "C" void kernel_launch(void* const* d_in, const int* in_sizes, int n_in, void* d_out, int out_size, void* d_ws, size_t ws_size, hipStream_t stream) {
    static int grid = 0;
    if (grid == 0) {
        if (n_in != 21 || in_sizes[0] != MLAT * DM || out_size != MLAT * DM || ws_size < WS_END) {
            fprintf(stderr, "kernel_launch: shape mismatch n_in %d in0 %d out %d ws %zu (need %zu)\n", n_in, n_in > 0 ? in_sizes[0] : -1, out_size, ws_size, (size_t)WS_END); grid = -1; return; }
        int dev = 0, cus = 0, per_cu = 0;
        hipGetDevice(&dev); hipDeviceGetAttribute(&cus, hipDeviceAttributeMultiprocessorCount, dev);
        if (hipFuncSetAttribute((const void*)fwd, hipFuncAttributeMaxDynamicSharedMemorySize, LDS_BYTES) != hipSuccess) { fprintf(stderr, "kernel_launch: hipFuncSetAttribute failed\n"); grid = -1; return; }
        if (hipOccupancyMaxActiveBlocksPerMultiprocessor(&per_cu, (const void*)fwd, 512, LDS_BYTES) != hipSuccess || per_cu < 1) { fprintf(stderr, "kernel_launch: occupancy query says %d\n", per_cu); per_cu = 1; }
        (void)hipGetLastError();
        grid = cus;
        if (grid != 256) fprintf(stderr, "kernel_launch: note: %d CUs\n", grid);
    }
    if (grid < 0) return;
    hipMemsetAsync(d_ws, 0, ZERO_BYTES, stream);
    Args a{};
    for (int i = 0; i < 21; ++i) a.in[i] = (const float*)d_in[i];
    a.out = (float*)d_out; a.ws = (unsigned char*)d_ws;
#if MK_COOP
    a.ph_lo = 0; a.ph_hi = NPHASE;
    void* args[] = {&a};
    hipError_t e = hipLaunchCooperativeKernel((const void*)fwd, dim3(grid), dim3(512), args, LDS_BYTES, stream);
    if (e != hipSuccess) fprintf(stderr, "kernel_launch: cooperative launch failed: %s (grid %d)\n", hipGetErrorString(e), grid);
#else
    for (int p = 0; p < NPHASE; ++p) { a.ph_lo = p; a.ph_hi = p + 1; hipLaunchKernelGGL(fwd, dim3(grid), dim3(512), LDS_BYTES, stream, a); }
#endif
}
```

```cpp
#include <hip/hip_runtime.h>
#include <hip/hip_bf16.h>
#include <hip/hip_cooperative_groups.h>
#include <cstdio>
#include <cstdint>
namespace cg = cooperative_groups;

#ifndef REP4
#define REP4 1
#endif
#ifndef REP7
#define REP7 1
#endif
#ifndef REP2
#define REP2 1
#endif
#ifndef MK_COOP
#define MK_COOP 1
#endif

#define LAS __attribute__((address_space(3)))
typedef unsigned short bf16_t;
typedef short bf16x8 __attribute__((ext_vector_type(8)));
typedef short s16x4 __attribute__((ext_vector_type(4)));
typedef float f32x4 __attribute__((ext_vector_type(4)));
typedef float f32x2 __attribute__((ext_vector_type(2)));
typedef float f32x16 __attribute__((ext_vector_type(16)));
typedef unsigned u32x4 __attribute__((ext_vector_type(4)));
typedef unsigned u32x2 __attribute__((ext_vector_type(2)));

constexpr int DM = 1024, NB = 8, SEQ = 8192, CTXL = 256, EXT = SEQ + CTXL, MEXT = NB * EXT, MLAT = NB * SEQ;
constexpr int NH = 8, QKD = 96, QW = NH * QKD  , VW = 512, DFF = 4096;
constexpr int NWIN = 3328;
constexpr int YW = 1280;
constexpr int GW8 = 2048;
constexpr int Y_CQ = 0, Y_KR = 384, Y_CKV = 512, Y_POOL = 768, Y_GM = 1280, Y_GP = 2304;
constexpr float EPS = 1e-6f;
constexpr float QSCALE_LOG2E = 0.10206207261596575f * 1.4426950408889634f;
constexpr int NPHASE = 9;
constexpr int LDS_BYTES = 147456;

constexpr size_t KiB = 1024, MiB = 1024 * 1024;
constexpr size_t WS_R3_ = 296 * MiB;
constexpr size_t WS_MOD = 0, WS_BIAS2 = 256 * KiB, WS_SSQQ = 384 * KiB, WS_SSQKV = 656 * KiB, WS_SSQ2 = 928 * KiB, WS_SSQ3 = 1200 * KiB, ZERO_BYTES = 1536 * KiB;
constexpr size_t WS_BAR = 1472 * KiB;
constexpr size_t WS_XCNT = 1488 * KiB;
constexpr size_t WS_XBUF = WS_R3_;
constexpr size_t WS_TAB = 1536 * KiB;
constexpr size_t WS_WIN = 2 * MiB, WS_WUQ = 9 * MiB, WS_WUKV = 10 * MiB, WS_WBM = 11 * MiB, WS_WPP = 12 * MiB, WS_WOUT = 13 * MiB, WS_W1 = 15 * MiB, WS_W2 = 23 * MiB;
constexpr size_t WS_R1 = 32 * MiB;
constexpr size_t WS_H = WS_R1, WS_Q = WS_R1, WS_K = WS_R1 + 99 * MiB, WS_V = WS_R1 + 198 * MiB, WS_MERGED = WS_R1;
constexpr size_t WS_R3 = 296 * MiB;
constexpr size_t WS_DPOOL = WS_R3, WS_ATTN = WS_R3 + 66 * MiB, WS_X1S = WS_R3;
constexpr size_t WS_R2 = 428 * MiB;
constexpr size_t WS_Y = WS_R2, WS_G8 = WS_R2 + 166 * MiB, WS_U = WS_R2;
constexpr size_t WS_END = 956 * MiB;
static_assert((size_t)MEXT * 1024 * 2 == 132 * MiB && (size_t)MEXT * 768 * 2 == 99 * MiB && (size_t)MEXT * 512 * 2 == 66 * MiB, "sizes");
static_assert((size_t)MEXT * DFF * 2 == 528 * MiB && (size_t)MEXT * YW * 2 <= 166 * MiB && (size_t)MEXT * GW8 == 132 * MiB, "sizes");

struct Args { const float* in[21]; float* out; unsigned char* ws; int ph_lo, ph_hi; };

__device__ __forceinline__ unsigned cvt_pk_bf16(float lo, float hi) { unsigned r; asm volatile("v_cvt_pk_bf16_f32 %0, %1, %2" : "=v"(r) : "v"(lo), "v"(hi)); return r; }
__device__ __forceinline__ float bf_lo(unsigned w) { return __uint_as_float(w << 16); }
__device__ __forceinline__ float bf_hi(unsigned w) { return __uint_as_float(w & 0xffff0000u); }
__device__ __forceinline__ float wave_sum(float v) {
#pragma unroll
    for (int o = 1; o < 64; o <<= 1) v += __shfl_xor(v, o);
    return v;
}
__device__ __forceinline__ float sigmoidf_(float x) { return __builtin_amdgcn_rcpf(1.f + __expf(-x)); }
__device__ __forceinline__ u32x4 pack8(f32x4 a, f32x4 b) { u32x4 w; w.x = cvt_pk_bf16(a[0], a[1]); w.y = cvt_pk_bf16(a[2], a[3]); w.z = cvt_pk_bf16(b[0], b[1]); w.w = cvt_pk_bf16(b[2], b[3]); return w; }
__device__ __forceinline__ void unpack8(u32x4 w, f32x4& a, f32x4& b) { a = (f32x4){bf_lo(w.x), bf_hi(w.x), bf_lo(w.y), bf_hi(w.y)}; b = (f32x4){bf_lo(w.z), bf_hi(w.z), bf_lo(w.w), bf_hi(w.w)}; }

namespace pg8 {
constexpr int BM = 256, BK = 64, HALF = 128, HTB = HALF * BK * 2, STAGE_BYTES = 8 * HTB, NXCD = 8, WGM = 8;
__host__ __device__ __forceinline__ int lds_byte(int r, int c) { const int st = (r >> 4) * 2 + (c >> 5), rr = r & 15, cc = c & 31, ob = rr * 64 + cc * 2; return st * 1024 + (ob ^ (((ob >> 9) & 1) << 5)); }
__host__ __device__ __forceinline__ void stage_rc(int b, int& R, int& C) { const int st = b / 1024, sb = b % 1024, swz = sb ^ (((sb >> 9) & 1) << 5); R = (st >> 1) * 16 + swz / 64; C = (st & 1) * 32 + (swz % 64) / 2; }
__host__ __device__ __forceinline__ int perm32(int rho) { const int n = rho >> 4, i = rho & 15; return 8 * (i >> 2) + 4 * n + (i & 3); }

struct Unit { int pm, pn, rnd; };
struct Gemm { const bf16_t* A; const bf16_t* Bt; int lda, K, tiledA = 0; };

struct Order {
    int nM, nN, nwg, G, c, latent;
    __device__ void init(int nM_, int nN_, int G_, int c_, int latent_) { nM = nM_; nN = nN_; nwg = nM * nN; G = G_; c = c_; latent = latent_; }
    __device__ bool next(int i, Unit& u) const {
        const long L = (long)i * G + c; if (L >= nwg) return false;
        int wgid = (int)L; { const int q = nwg / NXCD, r = nwg % NXCD, xcd = wgid % NXCD, off = wgid / NXCD; wgid = (xcd < r ? xcd * (q + 1) : r * (q + 1) + (xcd - r) * q) + off; }
        const int nig = WGM * nN, gid = wgid / nig, fm = gid * WGM, gsz = (nM - fm) < WGM ? (nM - fm) : WGM;
        int pm = fm + ((wgid % nig) % gsz); u.pn = (wgid % nig) / gsz;
        u.pm = latent ? pm + (pm >> 5) + 1 : pm; u.rnd = i; return true;
    }
};

template <class Epi, class Sched>
__device__ __forceinline__ void gemm_phase(LAS unsigned char* lds, const Gemm g, const Sched& S, const Epi& E) {
    int tid_ = threadIdx.x; asm volatile("" : "+v"(tid_));
    const int tid = tid_, wid = __builtin_amdgcn_readfirstlane(tid >> 6), lane = tid & 63, wr = wid >> 2, wc = wid & 3, fr = lane & 15, fq = lane >> 4;
    const int K = g.K, nt = K / BK, lda = g.lda;
    unsigned voffA[2], voffB[2];
#pragma unroll
    for (int i = 0; i < 2; ++i) { int R, C; stage_rc(tid * 16 + i * 8192, R, C); const int Rb = (R & ~31) + perm32(R & 31);
        voffA[i] = g.tiledA ? (unsigned)(tid * 16 + i * 8192) : (unsigned)(R * lda + C) * 2u; voffB[i] = (unsigned)(Rb * K + C) * 2u; }
    const size_t kstep = (size_t)(BK * 2), kstepA = g.tiledA ? (size_t)HTB : kstep;
    const size_t hstepA = g.tiledA ? (size_t)(K / BK) * HTB : (size_t)HALF * lda * 2, hstepB = (size_t)HALF * K * 2;
    const size_t tstepA = 2 * hstepA, tstepB = 2 * hstepB;
    const unsigned ldsw = (unsigned)wid * 1024u;
    const int aoff = lds_byte(wr * 64 + fr, fq * 8), boff = lds_byte(wc * 32 + fr, fq * 8);
#define PG8_SA(b, h) (((b) * 2 + (h)) * HTB)
#define PG8_SB(b, h) ((4 + (b) * 2 + (h)) * HTB)
#define PG8_STAGE(bufoff, gbase, voff) do { _Pragma("unroll") for (int _i = 0; _i < 2; ++_i) \
        __builtin_amdgcn_global_load_lds((const unsigned*)((const char*)(gbase) + (voff)[_i]), (LAS unsigned*)(lds + (bufoff) + ldsw + _i * 8192), 16, 0, 0); } while (0)
#define PG8_LDA(dst, b, h) do { _Pragma("unroll") for (int m = 0; m < 4; ++m) _Pragma("unroll") for (int k = 0; k < 2; ++k) dst[m][k] = *(const LAS bf16x8*)(lds + PG8_SA(b, h) + aoff + m * 2048 + k * 1024); } while (0)
#define PG8_LDB(dst, b, h) do { _Pragma("unroll") for (int n = 0; n < 2; ++n) _Pragma("unroll") for (int k = 0; k < 2; ++k) dst[n][k] = *(const LAS bf16x8*)(lds + PG8_SB(b, h) + boff + n * 2048 + k * 1024); } while (0)
#define PG8_MMA(ai, bj, At, Bt) do { __builtin_amdgcn_s_setprio(1); _Pragma("unroll") for (int m = 0; m < 4; ++m) _Pragma("unroll") for (int n = 0; n < 2; ++n) _Pragma("unroll") for (int k = 0; k < 2; ++k) \
        acc[ai][bj][m][n] = __builtin_amdgcn_mfma_f32_16x16x32_bf16(Bt[n][k], At[m][k], acc[ai][bj][m][n], 0, 0, 0); __builtin_amdgcn_s_setprio(0); } while (0)
#define PG8_WAIT_V(n) asm volatile("s_waitcnt vmcnt(" #n ")" ::: "memory")
#define PG8_WAIT_L(n) asm volatile("s_waitcnt lgkmcnt(" #n ")" ::: "memory")
#define PG8_BAR __builtin_amdgcn_s_barrier()
#define PG8_SCHED __builtin_amdgcn_sched_barrier(0)
    Unit cur, nxt; int ui = 0;
    if (!S.next(0, cur)) return;
    f32x4 acc[2][2][4][2];
#pragma unroll
    for (int a = 0; a < 2; ++a)
#pragma unroll
        for (int b = 0; b < 2; ++b)
#pragma unroll
            for (int m = 0; m < 4; ++m)
#pragma unroll
                for (int n = 0; n < 2; ++n) acc[a][b][m][n] = (f32x4){0.f, 0.f, 0.f, 0.f};
    bf16x8 At[4][2], B0[2][2], B1[2][2];
    const char* cA = (const char*)g.A + (size_t)cur.pm * tstepA; const char* cB = (const char*)g.Bt + (size_t)cur.pn * tstepB;
    PG8_STAGE(PG8_SB(0, 0), cB, voffB); PG8_STAGE(PG8_SB(0, 1), cB + hstepB, voffB); PG8_STAGE(PG8_SA(0, 0), cA, voffA); PG8_STAGE(PG8_SA(0, 1), cA + hstepA, voffA);
    if (wr == 1) PG8_BAR;
    PG8_WAIT_V(2); PG8_BAR;
    PG8_STAGE(PG8_SB(1, 0), cB + kstep, voffB); PG8_STAGE(PG8_SA(1, 0), cA + kstepA, voffA); PG8_STAGE(PG8_SB(1, 1), cB + hstepB + kstep, voffB);
    PG8_WAIT_V(6); PG8_BAR;
    for (;;) {
        const bool has_next = S.next(ui + 1, nxt);
        const char* nA = has_next ? (const char*)g.A + (size_t)nxt.pm * tstepA : cA; const char* nB = has_next ? (const char*)g.Bt + (size_t)nxt.pn * tstepB : cB;
#pragma unroll 1
        for (int t = 0; t < nt; t += 2) {
            const bool last = (t == nt - 2);
            const char* a1 = cA + (size_t)(t + 1) * kstepA;
            const char* a2 = last ? nA : cA + (size_t)(t + 2) * kstepA; const char* b2 = last ? nB : cB + (size_t)(t + 2) * kstep;
            const char* a3 = a2 + kstepA; const char* b3 = b2 + kstep;
            PG8_LDB(B0, 0, 0); PG8_LDB(B1, 0, 1); PG8_SCHED; PG8_LDA(At, 0, 0); PG8_STAGE(PG8_SA(1, 1), a1 + hstepA, voffA);
            PG8_WAIT_V(8); PG8_WAIT_L(0); PG8_BAR; PG8_MMA(0, 0, At, B0); PG8_MMA(0, 1, At, B1); PG8_BAR; PG8_SCHED;
            PG8_LDA(At, 0, 1); PG8_STAGE(PG8_SB(0, 0), b2, voffB); PG8_STAGE(PG8_SB(0, 1), b2 + hstepB, voffB); PG8_STAGE(PG8_SA(0, 0), a2, voffA);
            PG8_WAIT_V(8); PG8_WAIT_L(0); PG8_BAR; PG8_MMA(1, 0, At, B0); PG8_MMA(1, 1, At, B1); PG8_BAR; PG8_SCHED;
            PG8_LDB(B0, 1, 0); PG8_LDB(B1, 1, 1); PG8_SCHED; PG8_LDA(At, 1, 0); PG8_STAGE(PG8_SA(0, 1), a2 + hstepA, voffA);
            PG8_WAIT_V(8); PG8_WAIT_L(0); PG8_BAR; PG8_MMA(0, 0, At, B0); PG8_MMA(0, 1, At, B1); PG8_BAR; PG8_SCHED;
            PG8_LDA(At, 1, 1); PG8_STAGE(PG8_SB(1, 0), b3, voffB); PG8_STAGE(PG8_SB(1, 1), b3 + hstepB, voffB); PG8_STAGE(PG8_SA(1, 0), a3, voffA);
            PG8_WAIT_V(8); PG8_WAIT_L(0); PG8_BAR; PG8_MMA(1, 0, At, B0); PG8_MMA(1, 1, At, B1); PG8_BAR; PG8_SCHED;
        }
        if (wr == 0) PG8_BAR;
        E(acc, cur, wr, wc, fr, fq);
        if (!has_next) break;
#pragma unroll
        for (int a = 0; a < 2; ++a)
#pragma unroll
            for (int b = 0; b < 2; ++b)
#pragma unroll
                for (int m = 0; m < 4; ++m)
#pragma unroll
                    for (int n = 0; n < 2; ++n) acc[a][b][m][n] = (f32x4){0.f, 0.f, 0.f, 0.f};
        cur = nxt; cA = nA; cB = nB; ++ui;
        if (wr == 1) PG8_BAR;
    }
    PG8_WAIT_V(0);
    PG8_BAR;
#undef PG8_SA
#undef PG8_SB
#undef PG8_STAGE
#undef PG8_LDA
#undef PG8_LDB
#undef PG8_MMA
#undef PG8_WAIT_V
#undef PG8_WAIT_L
#undef PG8_BAR
#undef PG8_SCHED
}

typedef f32x4 (&AccRef)[2][2][4][2];
#define EPI_ROWS(u) const int row0_ = (u).pm * BM + wr * 64 + fr; const int colb_ = (u).pn * BM + wc * 32 + 8 * fq;
#define EPI_ROW(ai, m) (row0_ + (ai) * HALF + (m) * 16)
#define EPI_COL(bj) (colb_ + (bj) * HALF)

struct EpiY { bf16_t* Y; unsigned char* G8; float* ssq_q; float* ssq_kv;
    __device__ __forceinline__ void operator()(AccRef acc, const Unit& u, int wr, int wc, int fr, int fq) const {
        EPI_ROWS(u)
        if (u.pn >= 5) {
#pragma unroll
            for (int ai = 0; ai < 2; ++ai)
#pragma unroll
                for (int m = 0; m < 4; ++m) { const int row = EPI_ROW(ai, m);
#pragma unroll
                    for (int bj = 0; bj < 2; ++bj) { const f32x4 v0 = acc[ai][bj][m][0], v1 = acc[ai][bj][m][1]; unsigned q[8];
#pragma unroll
                        for (int i = 0; i < 4; ++i) { q[i] = (unsigned)(sigmoidf_(v0[i]) * 255.f + 0.5f); q[4 + i] = (unsigned)(sigmoidf_(v1[i]) * 255.f + 0.5f); }
                        u32x2 w; w.x = q[0] | (q[1] << 8) | (q[2] << 16) | (q[3] << 24); w.y = q[4] | (q[5] << 8) | (q[6] << 16) | (q[7] << 24);
                        *(u32x2*)(G8 + (size_t)row * GW8 + (EPI_COL(bj) - 1280)) = w; } }
            return; }
        const int mode = (u.pn == 0) ? 1 : (u.pn == 1 ? 2 : (u.pn == 2 ? 3 : 0));
#pragma unroll
        for (int ai = 0; ai < 2; ++ai)
#pragma unroll
            for (int m = 0; m < 4; ++m) { const int row = EPI_ROW(ai, m); float s = 0.f;
#pragma unroll
                for (int bj = 0; bj < 2; ++bj) { const f32x4 v0 = acc[ai][bj][m][0], v1 = acc[ai][bj][m][1];
                    *(u32x4*)(Y + (size_t)row * YW + EPI_COL(bj)) = pack8(v0, v1);
                    if (mode == 1 || mode == 3 || (mode == 2 && bj == 0)) s += (v0[0] * v0[0] + v0[1] * v0[1]) + (v0[2] * v0[2] + v0[3] * v0[3]) + (v1[0] * v1[0] + v1[1] * v1[1]) + (v1[2] * v1[2] + v1[3] * v1[3]); }
                if (mode) { s += __shfl_xor(s, 16); s += __shfl_xor(s, 32); if (fq == 0) unsafeAtomicAdd((mode == 3 ? ssq_kv : ssq_q) + row, s); } }
    }
};
struct EpiQ { bf16_t* Q; const float* ssq_q;
    __device__ __forceinline__ void operator()(AccRef acc, const Unit& u, int wr, int wc, int fr, int fq) const {
        EPI_ROWS(u)
#pragma unroll
        for (int ai = 0; ai < 2; ++ai)
#pragma unroll
            for (int m = 0; m < 4; ++m) { const int row = EPI_ROW(ai, m); const float rstd = QSCALE_LOG2E / sqrtf(ssq_q[row] * (1.0f / 384.0f) + EPS);
#pragma unroll
                for (int bj = 0; bj < 2; ++bj) *(u32x4*)(Q + (size_t)row * QW + EPI_COL(bj)) = pack8(acc[ai][bj][m][0] * rstd, acc[ai][bj][m][1] * rstd); }
    }
};
struct EpiKV { bf16_t* Kb; const float* ssq_kv;
    __device__ __forceinline__ void operator()(AccRef acc, const Unit& u, int wr, int wc, int fr, int fq) const {
        EPI_ROWS(u)
        const int bt = u.pm / 33;
#pragma unroll
        for (int ai = 0; ai < 2; ++ai)
#pragma unroll
            for (int m = 0; m < 4; ++m) { const int row = EPI_ROW(ai, m); const float rstd = 1.0f / sqrtf(ssq_kv[row] * (1.0f / 256.0f) + EPS);
#pragma unroll
                for (int bj = 0; bj < 2; ++bj) { const f32x4 v0 = acc[ai][bj][m][0] * rstd, v1 = acc[ai][bj][m][1] * rstd; const int col = EPI_COL(bj);
                    const int hh = (col >> 6) & 7, dd = col & 63; const size_t hk = (size_t)((bt * NH + hh) * EXT + (row - bt * EXT));
                    const int key_ = row - bt * EXT;
                    const size_t koff_ = ((size_t)((bt * NH + hh) * (EXT / 64) + (key_ >> 6)) * 12 + (dd >> 3)) * 512 + (size_t)(key_ & 63) * 8;
                    const size_t off = (col < 512) ? koff_ : (size_t)((WS_V - WS_K) / 2) + hk * 64 + dd;
                    *(u32x4*)(Kb + off) = pack8(v0, v1); } }
    }
};
template <int SECOND> struct EpiMerge { bf16_t* Mg; const unsigned char* G8;
    __device__ __forceinline__ void operator()(AccRef acc, const Unit& u, int wr, int wc, int fr, int fq) const {
        EPI_ROWS(u)
#pragma unroll
        for (int ai = 0; ai < 2; ++ai)
#pragma unroll
            for (int m = 0; m < 4; ++m) { const int row = EPI_ROW(ai, m);
#pragma unroll
                for (int bj = 0; bj < 2; ++bj) { const int col = EPI_COL(bj); const u32x2 gq = *(const u32x2*)(G8 + (size_t)row * GW8 + (SECOND ? 1024 : 0) + col);
                    f32x4 v0 = acc[ai][bj][m][0], v1 = acc[ai][bj][m][1];
#pragma unroll
                    for (int i = 0; i < 4; ++i) { v0[i] *= (float)((gq.x >> (8 * i)) & 255u) * (1.0f / 255.0f); v1[i] *= (float)((gq.y >> (8 * i)) & 255u) * (1.0f / 255.0f); }
                    bf16_t* dst = Mg + (size_t)row * DM + col;
                    if (SECOND) { f32x4 p0, p1; unpack8(*(const u32x4*)dst, p0, p1); v0 += p0; v1 += p1; }
                    *(u32x4*)dst = pack8(v0, v1); } }
    }
};
struct EpiOut { const float* x; bf16_t* x1b; bf16_t* x1s; const float* mod; const float* g2; float* ssq2;
    __device__ __forceinline__ void operator()(AccRef acc, const Unit& u, int wr, int wc, int fr, int fq) const {
        EPI_ROWS(u)
        const int bt = u.pm / 33; const float* mb = mod + bt * 6144;
        f32x4 gt[2][2], sc[2][2];
#pragma unroll
        for (int bj = 0; bj < 2; ++bj)
#pragma unroll
            for (int n = 0; n < 2; ++n) { const int col = EPI_COL(bj) + 4 * n; gt[bj][n] = *(const f32x4*)(mb + 2048 + col);
                const f32x4 g = *(const f32x4*)(g2 + col), s2 = *(const f32x4*)(mb + 4096 + col); sc[bj][n] = g * (s2 + 1.0f); }
#pragma unroll
        for (int ai = 0; ai < 2; ++ai)
#pragma unroll
            for (int m = 0; m < 4; ++m) { const int row = EPI_ROW(ai, m); const size_t lat = (size_t)(row - CTXL * (bt + 1)); float s = 0.f;
#pragma unroll
                for (int bj = 0; bj < 2; ++bj) { const int col = EPI_COL(bj); const size_t off = lat * DM + col;
                    const f32x4 x0 = *(const f32x4*)(x + off), x1 = *(const f32x4*)(x + off + 4);
                    const f32x4 v0 = x0 + gt[bj][0] * acc[ai][bj][m][0], v1 = x1 + gt[bj][1] * acc[ai][bj][m][1];
                    *(u32x4*)(x1b + (size_t)row * DM + col) = pack8(v0, v1);
                    s += (v0[0] * v0[0] + v0[1] * v0[1]) + (v0[2] * v0[2] + v0[3] * v0[3]) + (v1[0] * v1[0] + v1[1] * v1[1]) + (v1[2] * v1[2] + v1[3] * v1[3]);
                    *(u32x4*)(x1s + (size_t)row * DM + col) = pack8(v0 * sc[bj][0], v1 * sc[bj][1]); }
                s += __shfl_xor(s, 16); s += __shfl_xor(s, 32); if (fq == 0) unsafeAtomicAdd(ssq2 + row, s); }
    }
};
struct EpiUp { bf16_t* U; const float* ssq2; const float* bias2;
    __device__ __forceinline__ void operator()(AccRef acc, const Unit& u, int wr, int wc, int fr, int fq) const {
        EPI_ROWS(u)
        const int bt = u.pm / 33; f32x4 bs[2][2];
#pragma unroll
        for (int bj = 0; bj < 2; ++bj)
#pragma unroll
            for (int n = 0; n < 2; ++n) bs[bj][n] = *(const f32x4*)(bias2 + bt * DFF + EPI_COL(bj) + 4 * n);
#pragma unroll
        for (int ai = 0; ai < 2; ++ai)
#pragma unroll
            for (int m = 0; m < 4; ++m) { const int row = EPI_ROW(ai, m); const float rstd = 1.0f / sqrtf(ssq2[row] * (1.0f / 1024.0f) + EPS);
#pragma unroll
                for (int bj = 0; bj < 2; ++bj) { f32x4 v0 = acc[ai][bj][m][0] * rstd + bs[bj][0], v1 = acc[ai][bj][m][1] * rstd + bs[bj][1];
#pragma unroll
                    for (int i = 0; i < 4; ++i) { const float a = fmaxf(v0[i], 0.f), b = fmaxf(v1[i], 0.f); v0[i] = a * a; v1[i] = b * b; }
                    { const int c_ = EPI_COL(bj);
                      *(u32x4*)((char*)U + ((size_t)(row >> 7) * (DFF / 64) + (c_ >> 6)) * HTB + lds_byte(row & 127, c_ & 63)) = pack8(v0, v1); } } }
    }
};
struct EpiDown { float* out; const bf16_t* x1b; const float* mod; const float* fg; float* xbuf; unsigned* cnt; LAS unsigned char* lx;
    __device__ __forceinline__ void operator()(AccRef acc, const Unit& u, int wr, int wc, int fr, int fq) const {
        EPI_ROWS(u)
        const int bt = u.pm / 33; const float* mb = mod + bt * 6144;
        const int tid = threadIdx.x, wid = __builtin_amdgcn_readfirstlane(tid >> 6), lane = tid & 63;
        LAS float* P = (LAS float*)lx; LAS float* S = (LAS float*)(lx + 4096); volatile LAS unsigned* flag = (volatile LAS unsigned*)(lx + 5120);
        {   f32x4 gt[2][2];
#pragma unroll
            for (int bj = 0; bj < 2; ++bj)
#pragma unroll
                for (int n = 0; n < 2; ++n) gt[bj][n] = *(const f32x4*)(mb + 5120 + EPI_COL(bj) + 4 * n);
#pragma unroll
            for (int ai = 0; ai < 2; ++ai)
#pragma unroll
                for (int m = 0; m < 4; ++m) { const int row = EPI_ROW(ai, m); const size_t lat = (size_t)(row - CTXL * (bt + 1)); float s = 0.f;
#pragma unroll
                    for (int bj = 0; bj < 2; ++bj) { const size_t off = lat * DM + EPI_COL(bj);
                        f32x4 x0, x1; unpack8(*(const u32x4*)(x1b + (size_t)row * DM + EPI_COL(bj)), x0, x1);
                        const f32x4 v0 = x0 + gt[bj][0] * acc[ai][bj][m][0], v1 = x1 + gt[bj][1] * acc[ai][bj][m][1];
                        s += (v0[0] * v0[0] + v0[1] * v0[1]) + (v0[2] * v0[2] + v0[3] * v0[3]) + (v1[0] * v1[0] + v1[1] * v1[1]) + (v1[2] * v1[2] + v1[3] * v1[3]);
                        acc[ai][bj][m][0] = v0; acc[ai][bj][m][1] = v1; }
                    s += __shfl_xor(s, 16); s += __shfl_xor(s, 32);
                    if (fq == 0) P[(ai * HALF + wr * 64 + m * 16 + fr) * 4 + wc] = s;
                    asm volatile("" ::: "memory"); }
        }
        asm volatile("s_waitcnt lgkmcnt(0)" ::: "memory"); __builtin_amdgcn_s_barrier(); asm volatile("" ::: "memory");
        float* slot = xbuf + ((size_t)(u.rnd * (MEXT / 256) + u.pm) * 256) * 4;
        unsigned* cw = cnt + u.rnd * (MEXT / 256) + u.pm;
        if (tid < 256) { const float t4 = (P[tid * 4 + 0] + P[tid * 4 + 1]) + (P[tid * 4 + 2] + P[tid * 4 + 3]);
            __hip_atomic_store(slot + tid * 4 + u.pn, t4, __ATOMIC_RELAXED, __HIP_MEMORY_SCOPE_AGENT);
            asm volatile("s_waitcnt vmcnt(0)" ::: "memory");
            if (lane == 0) __hip_atomic_fetch_add(cw, 1u, __ATOMIC_RELAXED, __HIP_MEMORY_SCOPE_AGENT); }
        if (wid == 0) {
            unsigned sp = 0; bool dead = false;
            for (;;) { if ((unsigned)__builtin_amdgcn_readfirstlane(__hip_atomic_load(cw, __ATOMIC_RELAXED, __HIP_MEMORY_SCOPE_AGENT)) >= 16u) break;
                if (++sp > (1u << 22)) { dead = true; break; } __builtin_amdgcn_s_sleep(2); }
            __builtin_amdgcn_fence(__ATOMIC_ACQUIRE, "agent");
            if (lane == 0) flag[0] = dead ? 1u : 0u;
        }
        asm volatile("s_waitcnt vmcnt(0) lgkmcnt(0)" ::: "memory"); __builtin_amdgcn_s_barrier(); asm volatile("" ::: "memory");
        const bool bad = flag[0] != 0u;
        if (tid < 256) { float t4 = 0.f;
#pragma unroll
            for (int t = 0; t < 4; ++t) t4 += __hip_atomic_load(slot + tid * 4 + t, __ATOMIC_RELAXED, __HIP_MEMORY_SCOPE_AGENT);
            S[tid] = bad ? __builtin_nanf("") : 1.0f / sqrtf(t4 * (1.0f / DM) + EPS); }
        asm volatile("s_waitcnt vmcnt(0) lgkmcnt(0)" ::: "memory"); __builtin_amdgcn_s_barrier(); asm volatile("" ::: "memory");
        {   f32x4 fgv[2][2];
#pragma unroll
            for (int bj = 0; bj < 2; ++bj)
#pragma unroll
                for (int n = 0; n < 2; ++n) fgv[bj][n] = *(const f32x4*)(fg + EPI_COL(bj) + 4 * n);
#pragma unroll
            for (int ai = 0; ai < 2; ++ai)
#pragma unroll
                for (int m = 0; m < 4; ++m) { const int rl = ai * HALF + wr * 64 + m * 16 + fr; const float rs = S[rl]; const size_t lat = (size_t)(EPI_ROW(ai, m) - CTXL * (bt + 1));
#pragma unroll
                    for (int bj = 0; bj < 2; ++bj) { const size_t off = lat * DM + EPI_COL(bj);
                        *(f32x4*)(out + off) = acc[ai][bj][m][0] * rs * fgv[bj][0]; *(f32x4*)(out + off + 4) = acc[ai][bj][m][1] * rs * fgv[bj][1]; } }
        }
        asm volatile("s_waitcnt lgkmcnt(0)" ::: "memory"); __builtin_amdgcn_s_barrier(); asm volatile("" ::: "memory");
    }
};
}

namespace att {
using bf16 = __hip_bfloat16;
constexpr int NW = 8, QBLK = 32, KVBLK = 64;
constexpr float SCALE = 0.10206207261596575f;
constexpr float THR = 8.f;
constexpr int LDQ = QW, LDK = QKD, LDV = 64, LDO = VW;
constexpr int NSLOT = 3, KSLOT = 12288, VSLOT = 8192;
constexpr int LDS_K = 0, LDS_V = NSLOT * KSLOT, LDS_WS = LDS_V + NSLOT * VSLOT, SHM_ATTN = LDS_WS + NW * 64 * 4;
#define SBAR() __builtin_amdgcn_sched_barrier(0)
__device__ __forceinline__ int crow(int r, int hi) { return (r & 3) + 8 * (r >> 2) + 4 * hi; }
__device__ __forceinline__ unsigned cvtpk(float lo, float hi) { unsigned r; asm volatile("v_cvt_pk_bf16_f32 %0, %1, %2" : "=v"(r) : "v"(lo), "v"(hi)); return r; }
__device__ __forceinline__ bf16x8 ld8(const bf16* p) { return *reinterpret_cast<const bf16x8*>(p); }
__device__ __forceinline__ void glds16(const void* gsrc, unsigned lds_dst) { unsigned keep;
  asm volatile("s_mov_b32 %0, m0\n\ts_mov_b32 m0, %2\n\ts_nop 0\n\tglobal_load_lds_dwordx4 %1, off\n\ts_mov_b32 m0, %0" : "=&s"(keep) : "v"(gsrc), "s"(lds_dst) : "memory"); }

__device__ __forceinline__ void glds16s(unsigned voff, const void* sbase, unsigned lds_dst) { unsigned keep;
  asm volatile("s_mov_b32 %0, m0\n\ts_mov_b32 m0, %3\n\ts_nop 0\n\tglobal_load_lds_dwordx4 %1, %2\n\ts_mov_b32 m0, %0" : "=&s"(keep) : "v"(voff), "s"(sbase), "s"(lds_dst) : "memory"); }
__device__ __forceinline__ float rowmax32(const f32x16& p0, const f32x16& p1) {
  float pmax = p0[0];
#pragma unroll
  for (int r = 1; r < 16; ++r) pmax = fmaxf(pmax, p0[r]);
#pragma unroll
  for (int r = 0; r < 16; ++r) pmax = fmaxf(pmax, p1[r]);
  auto rr = __builtin_amdgcn_permlane32_swap(__float_as_uint(pmax), __float_as_uint(pmax), false, false);
  return fmaxf(__uint_as_float(rr[0]), __uint_as_float(rr[1]));
}
constexpr float THR2 = THR * 1.4426950408889634f;
__device__ __forceinline__ void decide(const f32x16& p0, const f32x16& p1, float& mhat, f32x16& negm, float& alpha) {
  const float pmax = rowmax32(p0, p1);
  if (__builtin_expect(__all(pmax <= THR2), 1)) { alpha = 1.f; }
  else { const float dl = fmaxf(pmax, 0.f); mhat += dl;
#pragma unroll
    for (int r = 0; r < 16; ++r) negm[r] = -mhat;
    alpha = __builtin_amdgcn_exp2f(-dl); }
}
__device__ __forceinline__ void guard(float ps, float& mhat, f32x16& negm, float& alpha) {
  constexpr float BIG = 1073741824.f;
  if (__builtin_expect(__all(ps <= BIG), 1)) { alpha = 1.f; }
  else { mhat += 30.f;
#pragma unroll
    for (int r = 0; r < 16; ++r) negm[r] = -mhat;
    alpha = 9.313225746154785e-10f; }
}
__device__ __forceinline__ void exps32(f32x16& p0, f32x16& p1) {
#pragma unroll
  for (int r = 0; r < 16; ++r) p0[r] = __builtin_amdgcn_exp2f(p0[r]);
#pragma unroll
  for (int r = 0; r < 16; ++r) p1[r] = __builtin_amdgcn_exp2f(p1[r]);
}
__device__ __forceinline__ void finishP(const f32x16& p0, const f32x16& p1, float alpha, float& l_reg, bf16x8& pa0, bf16x8& pa1, bf16x8& pa2, bf16x8& pa3, float& ps_out) {
  float ps = 0, ps2 = 0;
#pragma unroll
  for (int r = 0; r < 16; ++r) ps += p0[r];
#pragma unroll
  for (int r = 0; r < 16; ++r) ps2 += p1[r];
  ps += ps2;
  l_reg = (l_reg + ps) * alpha; ps_out = ps;
#define PK4(P, BASE, OUT) do { unsigned a0 = cvtpk(P[BASE + 0], P[BASE + 1]), a1 = cvtpk(P[BASE + 2], P[BASE + 3]);   \
    unsigned b0 = cvtpk(P[BASE + 4], P[BASE + 5]), b1 = cvtpk(P[BASE + 6], P[BASE + 7]);                              \
    u32x4 w = {a0, a1, b0, b1}; OUT = *reinterpret_cast<bf16x8*>(&w); } while (0)
  PK4(p0, 0, pa0); PK4(p0, 8, pa1); PK4(p1, 0, pa2); PK4(p1, 8, pa3);
#undef PK4
}
__device__ __forceinline__ void qkt(f32x16& p0, f32x16& p1, const char* Ks, const bf16x8* qr, const f32x16& negm) {
#pragma unroll
  for (int d0 = 0; d0 < 6; ++d0) {
    bf16x8 b0 = *reinterpret_cast<const bf16x8*>(Ks + d0 * 2048);
    bf16x8 b1 = *reinterpret_cast<const bf16x8*>(Ks + d0 * 2048 + 512);
    if (d0 == 0) { p0 = __builtin_amdgcn_mfma_f32_32x32x16_bf16(b0, qr[0], negm, 0, 0, 0); p1 = __builtin_amdgcn_mfma_f32_32x32x16_bf16(b1, qr[0], negm, 0, 0, 0); }
    else { p0 = __builtin_amdgcn_mfma_f32_32x32x16_bf16(b0, qr[d0], p0, 0, 0, 0); p1 = __builtin_amdgcn_mfma_f32_32x32x16_bf16(b1, qr[d0], p1, 0, 0, 0); } }
}
__device__ __forceinline__ int v_rd_base(int lane) { return ((lane & 3) << 3) | (((lane >> 2) & 3) << 6) | (((lane >> 4) & 1) << 5) | (((lane >> 5) & 1) << 8); }
constexpr int v_rd_off(int d0, int ks, int half) { return d0 * 512 + ks * 2048 + half * 1024; }
template <int OFF> __device__ __forceinline__ s16x4 tr_read(int vb) {
  s16x4 r; asm volatile("ds_read_b64_tr_b16 %0, %1 offset:%2" : "=&v"(r) : "v"(vb), "i"(OFF) : "memory"); return r;
}
struct VF { s16x4 l[2][4], h[2][4]; };
__device__ __forceinline__ void v_read(VF& f, int vb) {
#define VR(D0, KS) f.l[D0][KS] = tr_read<v_rd_off(D0, KS, 0)>(vb); f.h[D0][KS] = tr_read<v_rd_off(D0, KS, 1)>(vb);
  VR(0, 0) VR(0, 1) VR(0, 2) VR(0, 3) VR(1, 0) VR(1, 1) VR(1, 2) VR(1, 3)
#undef VR
}
__device__ __forceinline__ void v_wait(VF& f) {
  asm volatile("s_waitcnt lgkmcnt(0)" : "+v"(f.l[0][0]), "+v"(f.l[0][1]), "+v"(f.l[0][2]), "+v"(f.l[0][3]), "+v"(f.h[0][0]), "+v"(f.h[0][1]), "+v"(f.h[0][2]), "+v"(f.h[0][3]),
               "+v"(f.l[1][0]), "+v"(f.l[1][1]), "+v"(f.l[1][2]), "+v"(f.l[1][3]), "+v"(f.h[1][0]), "+v"(f.h[1][1]), "+v"(f.h[1][2]), "+v"(f.h[1][3]) :: "memory");
}
__device__ __forceinline__ void pv_mma(f32x16* o, const VF& f, bf16x8 pa0, bf16x8 pa1, bf16x8 pa2, bf16x8 pa3) {
#define PK(L, H) (bf16x8){L[0], L[1], L[2], L[3], H[0], H[1], H[2], H[3]}
#pragma unroll
  for (int d = 0; d < 2; ++d) {
    o[d] = __builtin_amdgcn_mfma_f32_32x32x16_bf16(pa0, PK(f.l[d][0], f.h[d][0]), o[d], 0, 0, 0);
    o[d] = __builtin_amdgcn_mfma_f32_32x32x16_bf16(pa1, PK(f.l[d][1], f.h[d][1]), o[d], 0, 0, 0);
    o[d] = __builtin_amdgcn_mfma_f32_32x32x16_bf16(pa2, PK(f.l[d][2], f.h[d][2]), o[d], 0, 0, 0);
    o[d] = __builtin_amdgcn_mfma_f32_32x32x16_bf16(pa3, PK(f.l[d][3], f.h[d][3]), o[d], 0, 0, 0); }
#undef PK
}

__device__ __forceinline__ void attn_unit(const bf16* __restrict__ Qb, const bf16* __restrict__ Kh, const bf16* __restrict__ Vh, bf16* __restrict__ Ob, int seq, char* lds, const float* __restrict__ tab, int t0) {
  int tid_ = threadIdx.x; asm volatile("" : "+v"(tid_));
  const int tid = tid_, lane = tid & 63, r32 = lane & 31, hi = lane >> 5; const int wid = __builtin_amdgcn_readfirstlane(tid >> 6);
  const unsigned lds0 = (unsigned)(uintptr_t)lds;
  float* ws = (float*)(lds + LDS_WS) + wid * 64; float* li_l = ws; float* al_l = ws + 32;
  float mhat = 0.f, l_reg = 0; f32x16 o[2] = {}; bf16x8 qr[6]; f32x16 negm = f32x16{}; asm volatile("" : "+v"(negm));
  const bf16* Qw = Qb + (long)(wid * QBLK + r32) * LDQ + hi * 8;
#pragma unroll
  for (int d0 = 0; d0 < 6; ++d0) qr[d0] = ld8(Qw + d0 * 16);
  { const int tq = t0 + wid * QBLK + r32;
#pragma unroll
    for (int part = 0; part < 2; ++part) { const int pos = part ? (tq & 63) : (tq >> 6); const float* tp = tab + pos * 16 + hi * 8;
      const f32x4 c0 = *(const f32x4*)tp, c1 = *(const f32x4*)(tp + 4);
      const f32x4 cs = (f32x4){c0[0], c0[2], c1[0], c1[2]}, sn = (f32x4){c0[1], c0[3], c1[1], c1[3]};
      const u32x4 w = __builtin_bit_cast(u32x4, qr[4 + part]); f32x4 x1, x2; unpack8(w, x1, x2);
      qr[4 + part] = __builtin_bit_cast(bf16x8, pack8(x1 * cs - x2 * sn, x1 * sn + x2 * cs)); } }
  const bool k2 = wid < 4;
  const unsigned koffA = (unsigned)(wid * 512 + lane * 8) * 2u, koffB = (unsigned)((8 + (wid & 3)) * 512 + lane * 8) * 2u;
  const int vkk = wid * 8 + ((lane >> 2) & 7), vkey = vkk;
  const unsigned voffV = (unsigned)(vkey * LDV + (lane >> 5) * 32 + (lane & 3) * 8) * 2u;
  const unsigned kdstA = lds0 + LDS_K + wid * 1024, kdstB = lds0 + LDS_K + (8 + (wid & 3)) * 1024, vdst = lds0 + LDS_V + wid * 1024;
#define DMA_K(t, slot) do { const bf16* kb_ = Kh + (long)(t) * KVBLK * LDK; glds16s(koffA, kb_, (unsigned)__builtin_amdgcn_readfirstlane(kdstA + (slot) * KSLOT)); \
    if (k2) glds16s(koffB, kb_, (unsigned)__builtin_amdgcn_readfirstlane(kdstB + (slot) * KSLOT)); } while (0)
#define DMA_V(t, slot) glds16s(voffV, Vh + (long)(t) * KVBLK * LDV, (unsigned)__builtin_amdgcn_readfirstlane(vdst + (slot) * VSLOT))
#define WAIT_ALL_BAR() asm volatile("s_waitcnt vmcnt(0) lgkmcnt(0)\n\ts_barrier" ::: "memory")
#define WAIT_STEP_BAR() do { if (k2) asm volatile("s_waitcnt vmcnt(3) lgkmcnt(0)\n\ts_barrier" ::: "memory"); else asm volatile("s_waitcnt vmcnt(2) lgkmcnt(0)\n\ts_barrier" ::: "memory"); } while (0)
#define RESC(a) do { if (__any((a) < 1.f)) { \
    _Pragma("unroll") for (int d = 0; d < 2; ++d) _Pragma("unroll") for (int r = 0; r < 16; ++r) o[d][r] *= (a); } } while (0)
  const char* kp0 = lds + LDS_K + hi * 1024 + r32 * 16;
  const int vb0 = (int)(lds0 + LDS_V) + v_rd_base(lane);
  f32x16 pA0, pA1, pB0, pB1; float alA, alB, psum; bf16x8 pa0, pa1, pa2, pa3; VF vf; const int NT = seq / KVBLK;
  int s_prev = 2, s_cur = 0, s_next = 1;
#define ROT() do { const int t_ = s_prev; s_prev = s_cur; s_cur = s_next; s_next = t_; } while (0)
#define STEP(N0, N1, O0, O1, alN, alO, t) do { \
    const bool full_ = (t) + 2 < NT; \
    qkt(N0, N1, kp0 + s_cur * KSLOT, qr, negm); \
    finishP(O0, O1, alO, l_reg, pa0, pa1, pa2, pa3, psum); \
    _Pragma("unroll") for (int g_ = 0; g_ < 12; ++g_) { __builtin_amdgcn_sched_group_barrier(0x008, 1, 0); __builtin_amdgcn_sched_group_barrier(0x002, 5, 0); } \
    v_read(vf, vb0 + s_prev * VSLOT);     \
    if (full_) DMA_K((t) + 2, s_prev); if ((t) + 1 < NT) DMA_V((t) + 1, s_next);     \
    guard(psum, mhat, negm, alN); v_wait(vf); \
    pv_mma(o, vf, pa0, pa1, pa2, pa3); exps32(N0, N1); asm volatile("" : "+v"(N0), "+v"(N1)); \
    _Pragma("unroll") for (int g_ = 0; g_ < 8; ++g_) { __builtin_amdgcn_sched_group_barrier(0x008, 1, 0); __builtin_amdgcn_sched_group_barrier(0x002, 4, 0); } \
    RESC(alO); \
    if (full_) WAIT_STEP_BAR(); else WAIT_ALL_BAR(); \
    ROT(); } while (0)
  DMA_K(0, 0); DMA_V(0, 0); DMA_K(1, 1);
  WAIT_ALL_BAR();
  DMA_K(2, 2); DMA_V(1, 1);
  qkt(pA0, pA1, kp0, qr, negm);
  { const float dl = rowmax32(pA0, pA1); mhat = dl;
#pragma unroll
    for (int r = 0; r < 16; ++r) { pA0[r] -= dl; pA1[r] -= dl; }
#pragma unroll
    for (int r = 0; r < 16; ++r) negm[r] = -mhat;
    asm volatile("" : "+v"(negm)); alA = 1.f; }
  exps32(pA0, pA1); asm volatile("" : "+v"(pA0), "+v"(pA1));
  WAIT_ALL_BAR(); ROT();
  int t = 1;
  for (; t + 1 < NT; t += 2) {
    STEP(pB0, pB1, pA0, pA1, alB, alA, t);
    STEP(pA0, pA1, pB0, pB1, alA, alB, t + 1);
  }
  STEP(pB0, pB1, pA0, pA1, alB, alA, t);
  v_read(vf, vb0 + s_prev * VSLOT);
  finishP(pB0, pB1, 1.f, l_reg, pa0, pa1, pa2, pa3, psum); v_wait(vf);
  pv_mma(o, vf, pa0, pa1, pa2, pa3);
  { auto rr = __builtin_amdgcn_permlane32_swap(__float_as_uint(l_reg), __float_as_uint(l_reg), false, false); l_reg = __uint_as_float(rr[0]) + __uint_as_float(rr[1]); }
  if (hi == 0) li_l[r32] = l_reg; asm volatile("s_waitcnt lgkmcnt(0)" ::: "memory");
  float rli[16];
#pragma unroll
  for (int r = 0; r < 16; ++r) rli[r] = __builtin_amdgcn_rcpf(li_l[crow(r, hi)]);
  bf16* Ow = Ob + (long)(wid * QBLK) * LDO;
#pragma unroll
  for (int r = 0; r < 16; ++r) { int orow = crow(r, hi);
#pragma unroll
    for (int d0 = 0; d0 < 2; ++d0) Ow[(long)orow * LDO + d0 * 32 + r32] = __float2bfloat16(o[d0][r] * rli[r]); }
  asm volatile("s_waitcnt vmcnt(0) lgkmcnt(0)\n\ts_barrier" ::: "memory");
#undef DMA_K
#undef DMA_V
#undef WAIT_ALL_BAR
#undef WAIT_STEP_BAR
#undef RESC
#undef ROT
#undef STEP
}
#undef SBAR
}


#define XB_TMO      128
#define XB_XCNT(j)  (256  + 64 * (j))
#define XB_XSUB(j)  (1280 + 64 * (j))
#define XB_XGEN(j)  (2304 + 64 * (j))
#define XB_TOP      3328
#define XB_TOPGEN   3392
#define XCD_BAR_WORDS 3456
#define XB_SPIN_CAP (1u << 22)
__device__ __forceinline__ unsigned xb_ld(unsigned* p)              { return __hip_atomic_load(p, __ATOMIC_RELAXED, __HIP_MEMORY_SCOPE_AGENT); }
__device__ __forceinline__ unsigned xb_add(unsigned* p, unsigned v) { return __hip_atomic_fetch_add(p, v, __ATOMIC_RELAXED, __HIP_MEMORY_SCOPE_AGENT); }
__device__ __forceinline__ unsigned xb_xcc_id() { return (unsigned)__builtin_amdgcn_s_getreg((3 << 11) | 20) & 0xFu; }
#define XB_SPIN(cond, bar) do { unsigned _sp = 0; while (cond) { __builtin_amdgcn_s_sleep(1); \
    if ((++_sp & 255u) == 0u) { if (xb_ld(&(bar)[XB_TMO])) break; if (_sp > XB_SPIN_CAP) { atomicAdd(&(bar)[XB_TMO], 1u); break; } } } } while (0)
struct XcdBarrier { unsigned* bar; unsigned x; volatile LAS unsigned* st; };
__device__ __forceinline__ XcdBarrier xcd_barrier_post(unsigned* bar, volatile LAS unsigned* st) {
    XcdBarrier b; b.bar = bar; b.x = xb_xcc_id(); b.st = st;
    if (threadIdx.x == 0) (void)xb_add(&bar[XB_XCNT(b.x)], 1u);
    return b;
}
__device__ __forceinline__ void xcd_barrier_complete(unsigned* bar, unsigned x, unsigned& nloc, unsigned& nx) {
    const unsigned G = gridDim.x * gridDim.y * gridDim.z;
    unsigned sum, cnt, mine, sp = 0u;
    for (;;) {
        sum = 0u; cnt = 0u; mine = 0u;
#pragma unroll
        for (unsigned j = 0; j < 16; ++j) { const unsigned c = xb_ld(&bar[XB_XCNT(j)]); sum += c; cnt += (c > 0u) ? 1u : 0u; mine = (j == x) ? c : mine; }
        if (sum == G) break;
        __builtin_amdgcn_s_sleep(1);
        if ((++sp & 255u) == 0u) { if (xb_ld(&bar[XB_TMO])) break; if (sp > XB_SPIN_CAP) { atomicAdd(&bar[XB_TMO], 1u); break; } }
    }
    nloc = mine > 0u ? mine : 1u; nx = cnt > 0u ? cnt : 1u;
}
__device__ __forceinline__ void xcd_barrier(const XcdBarrier& b) {
    asm volatile("s_waitcnt vmcnt(0)" ::: "memory");
    __syncthreads();
    if (threadIdx.x == 0) {
        unsigned* bar = b.bar;
        __builtin_amdgcn_s_waitcnt(0);
        unsigned nloc = b.st[0], nx = b.st[1];
        if (nloc == 0u) { xcd_barrier_complete(bar, b.x, nloc, nx); b.st[0] = nloc; b.st[1] = nx; }
        const unsigned old = xb_add(&bar[XB_XSUB(b.x)], 1u);
        const unsigned gen = old / nloc;
        if (old + 1u == (gen + 1u) * nloc) {
            __builtin_amdgcn_fence(__ATOMIC_RELEASE, "agent");
            asm volatile("s_waitcnt vmcnt(0)" ::: "memory");
            const unsigned og = xb_add(&bar[XB_TOP], 1u);
            const unsigned tg = og / nx;
            if (og + 1u == (tg + 1u) * nx) xb_add(&bar[XB_TOPGEN], 1u);
            else XB_SPIN(xb_ld(&bar[XB_TOPGEN]) == tg, bar);
            __builtin_amdgcn_fence(__ATOMIC_ACQUIRE, "agent");
            xb_add(&bar[XB_XGEN(b.x)], 1u);
            asm volatile("s_waitcnt vmcnt(0)" ::: "memory");
        } else {
            XB_SPIN(xb_ld(&bar[XB_XGEN(b.x)]) == gen, bar);
            __builtin_amdgcn_fence(__ATOMIC_ACQUIRE, "agent");
            asm volatile("s_waitcnt vmcnt(0)" ::: "memory");
        }
    }
    __syncthreads();
}

template <class RowMap>
__device__ __forceinline__ void transpose_item(const float* W, int K, int N, bf16_t* WT, LAS float* scr, int item, int lane, const float* kscale, RowMap rm) {
    const int nblk = N / 32, kb = item / nblk, nb = item % nblk, k0 = 64 * kb, n0 = 32 * nb;
#pragma unroll 8
    for (int i = 0; i < 32; ++i) { const int kk = 2 * i + (lane >> 5); float v = W[(size_t)(k0 + kk) * N + n0 + (lane & 31)]; if (kscale) v *= kscale[k0 + kk]; scr[kk * 33 + (lane & 31)] = v; }
    asm volatile("s_waitcnt lgkmcnt(0)" ::: "memory");
    const int c = lane & 7;
#pragma unroll
    for (int j = 0; j < 4; ++j) { const int n = (lane >> 3) + 8 * j; const LAS float* s = scr + (8 * c) * 33 + n;
        u32x4 o; o.x = cvt_pk_bf16(s[0 * 33], s[1 * 33]); o.y = cvt_pk_bf16(s[2 * 33], s[3 * 33]); o.z = cvt_pk_bf16(s[4 * 33], s[5 * 33]); o.w = cvt_pk_bf16(s[6 * 33], s[7 * 33]);
        *(u32x4*)(WT + (size_t)rm(n0 + n) * K + k0 + 8 * c) = o; }
    asm volatile("s_waitcnt lgkmcnt(0)" ::: "memory");
}
template <int NR>
__device__ __forceinline__ void gemv_item(const float* W, int N, const LAS float* sv, float* dst, const float* bias, int cgp, int ks, int lane) {
    const int col = cgp * 256 + lane * 4; f32x4 acc[NR];
#pragma unroll
    for (int b = 0; b < NR; ++b) acc[b] = (f32x4){0.f, 0.f, 0.f, 0.f};
    const float* wp = W + (size_t)(ks * 128) * N + col;
#pragma unroll 4
    for (int k = 0; k < 128; ++k) { const f32x4 w = *(const f32x4*)(wp + (size_t)k * N);
#pragma unroll
        for (int b = 0; b < NR; ++b) acc[b] += w * sv[b * 1024 + ks * 128 + k]; }
#pragma unroll
    for (int b = 0; b < NR; ++b) { if (bias && ks == 0) acc[b] += *(const f32x4*)(bias + col);
#pragma unroll
        for (int i = 0; i < 4; ++i) unsafeAtomicAdd(dst + (size_t)b * N + col + i, acc[b][i]); }
}

__global__ void __launch_bounds__(512, 2) fwd(Args a) {
    extern __shared__ __attribute__((aligned(16))) unsigned char lds_raw[];
    LAS unsigned char* lds = (LAS unsigned char*)lds_raw;
    const int tid = threadIdx.x, lane = tid & 63, wave = __builtin_amdgcn_readfirstlane(tid >> 6);
    const int G = gridDim.x, bx = blockIdx.x, gw = bx * 8 + wave, NGW = G * 8;
    unsigned char* ws = a.ws;
    float* mod = (float*)(ws + WS_MOD); float* bias2 = (float*)(ws + WS_BIAS2);
    float* ssq_q = (float*)(ws + WS_SSQQ); float* ssq_kv = (float*)(ws + WS_SSQKV); float* ssq2 = (float*)(ws + WS_SSQ2); float* ssq3 = (float*)(ws + WS_SSQ3);
    float* tab = (float*)(ws + WS_TAB);
    bf16_t* WinT = (bf16_t*)(ws + WS_WIN); bf16_t* WuqT = (bf16_t*)(ws + WS_WUQ); bf16_t* WukvT = (bf16_t*)(ws + WS_WUKV); bf16_t* WbmT = (bf16_t*)(ws + WS_WBM);
    bf16_t* WppT = (bf16_t*)(ws + WS_WPP); bf16_t* WoutT = (bf16_t*)(ws + WS_WOUT); bf16_t* W1T = (bf16_t*)(ws + WS_W1); bf16_t* W2T = (bf16_t*)(ws + WS_W2);
    bf16_t* Hb = (bf16_t*)(ws + WS_H); bf16_t* Qb = (bf16_t*)(ws + WS_Q); bf16_t* Kb = (bf16_t*)(ws + WS_K); bf16_t* Vb = (bf16_t*)(ws + WS_V); bf16_t* Mg = (bf16_t*)(ws + WS_MERGED);
    bf16_t* Dp = (bf16_t*)(ws + WS_DPOOL); bf16_t* At = (bf16_t*)(ws + WS_ATTN); bf16_t* X1s = (bf16_t*)(ws + WS_X1S);
    bf16_t* X1b = (bf16_t*)(ws + WS_R1 + 132 * MiB);
    unsigned char* G8b = ws + WS_G8;
    bf16_t* Yb = (bf16_t*)(ws + WS_Y); bf16_t* Ub = (bf16_t*)(ws + WS_U);
    const int lo = a.ph_lo, hi_ph = a.ph_hi;
#if MK_COOP
    volatile LAS unsigned* bst = (volatile LAS unsigned*)(lds + LDS_BYTES - 64);
    if (tid < 16) bst[tid] = 0u;
    __syncthreads();
    XcdBarrier bar = xcd_barrier_post((unsigned*)(ws + WS_BAR), bst);
    if (lo < 0) cg::this_grid().sync();
#endif
#ifndef PHMASK
#define PHMASK 0x1ff
#endif
#define IN(k) (((PHMASK >> (k)) & 1) && lo <= (k) && (k) < hi_ph)
#if MK_COOP
#define SEAM(k) do { if (IN(k) && IN((k) + 1)) xcd_barrier(bar); } while (0)
#else
#define SEAM(k) do { } while (0)
#endif

    if (IN(0)) {
        LAS float* sil = (LAS float*)(lds + 73728);
        for (int i = tid; i < 9 * 1024; i += 512) { const int b = i >> 10, k = i & 1023; const float v = (b < 8) ? a.in[1][b * 1024 + k] : a.in[3][k]; sil[i] = v / (1.f + __expf(-v)); }
        __syncthreads();
        LAS float* scr = (LAS float*)(lds + wave * 8448);
        constexpr int I_ADA = 24 * 8, I_PP = 1024, I_IN = 16 * 101, I_UQ = 6 * 24, I_UKV = 4 * 32, I_BM = 8 * 32, I_OUT = 16 * 32, I_W1 = 16 * 128, I_W2 = 64 * 32, I_PAD = 96, I_TAB = 1;
        constexpr int NITEMS = I_ADA + I_PP + I_IN + I_UQ + I_UKV + I_BM + I_OUT + I_W1 + I_W2 + I_PAD + I_TAB;
        auto ident = [](int n) { return n; };
        for (int it = gw; it < NITEMS; it += NGW) {
            int r = it;
            if (r < I_ADA) { gemv_item<9>(a.in[4], 6144, sil, mod, a.in[5], r >> 3, r & 7, lane); continue; } r -= I_ADA;
            if (r < I_PP) {
                const int kc = r >> 4, nb = r & 15, k0 = kc * 8, gI = k0 >> 7, c0 = k0 & 127, n = nb * 64 + lane;
                const float* pw = a.in[13] + (size_t)(gI * 128 + c0) * 128; const float* psc = a.in[14] + gI * 128; const float* wb = a.in[15] + (size_t)(gI * 128) * 1024 + n;
                float ac[8] = {0.f, 0.f, 0.f, 0.f, 0.f, 0.f, 0.f, 0.f};
#pragma unroll 4
                for (int d = 0; d < 128; ++d) { const float wv = wb[(size_t)d * 1024] * psc[d];
#pragma unroll
                    for (int i = 0; i < 8; ++i) ac[i] += pw[i * 128 + d] * wv; }
                u32x4 o; o.x = cvt_pk_bf16(ac[0], ac[1]); o.y = cvt_pk_bf16(ac[2], ac[3]); o.z = cvt_pk_bf16(ac[4], ac[5]); o.w = cvt_pk_bf16(ac[6], ac[7]);
                *(u32x4*)(WppT + (size_t)n * 512 + k0) = o; continue; } r -= I_PP;
            if (r < I_IN) { transpose_item(a.in[7], 1024, 3232, WinT, scr, r, lane, nullptr, [](int n) { return n < 384 ? n : (n < 640 ? n + 128 : (n < 672 ? n - 256 : n + 96)); }); continue; } r -= I_IN;
            if (r < I_UQ) { transpose_item(a.in[10], 384, 768, WuqT, scr, r, lane, a.in[8], [](int n) { const int d = n % 96; if (d < 64) return n; const int p = d - 64, part = p >> 4, half = (p >> 3) & 1, j = p & 7;
                                return n - d + 64 + 8 * (part * 2 + (j >> 2)) + 4 * half + (j & 3); }); continue; } r -= I_UQ;
            if (r < I_UKV) { transpose_item(a.in[11], 256, 1024, WukvT, scr, r, lane, a.in[9], [](int n) { const int h = n >> 7, e = n & 127; return e < 64 ? h * 64 + e : 512 + h * 64 + (e - 64); }); continue; } r -= I_UKV;
            if (r < I_BM) { transpose_item(a.in[12], 512, 1024, WbmT, scr, r, lane, nullptr, ident); continue; } r -= I_BM;
            if (r < I_OUT) { transpose_item(a.in[16], 1024, 1024, WoutT, scr, r, lane, nullptr, ident); continue; } r -= I_OUT;
            if (r < I_W1) { transpose_item(a.in[18], 1024, 4096, W1T, scr, r, lane, nullptr, ident); continue; } r -= I_W1;
            if (r < I_W2) { transpose_item(a.in[19], 4096, 1024, W2T, scr, r, lane, nullptr, ident); continue; } r -= I_W2;
            if (r < I_PAD) { u32x4 z = {0u, 0u, 0u, 0u}; u32x4* p = (u32x4*)(WinT + (size_t)(416 + r) * 1024); p[lane] = z; p[64 + lane] = z; continue; } r -= I_PAD;
            {
                for (int e = lane; e < 1024; e += 64) { const int pos = e >> 3, j = e & 7; const float invf = powf(10000.0f, -(float)(2 * j) / 16.0f); const float ang = (float)pos * invf;
                    tab[2 * e] = cosf(ang); tab[2 * e + 1] = sinf(ang); } }
        }
    }
    SEAM(0);

    if (IN(1)) {
        LAS float* sh2 = (LAS float*)(lds + 73728);
        for (int i = tid; i < 8 * 1024; i += 512) sh2[i] = mod[(i >> 10) * 6144 + 3072 + (i & 1023)];
        __syncthreads();
        if (gw < 128) gemv_item<8>(a.in[18], 4096, sh2, bias2, nullptr, gw >> 3, gw & 7, lane);
        const float* g1 = a.in[6];
        for (int r = gw; r < MEXT; r += NGW) {
            const int b = r / EXT, j = r - b * EXT; const bool isctx = j < CTXL;
            const float* src = isctx ? a.in[2] + (size_t)(b * CTXL + j) * DM : a.in[0] + (size_t)(b * SEQ + j - CTXL) * DM; const float* mb = mod + (isctx ? 8 : b) * 6144;
            f32x4 v[4]; float s = 0.f;
#pragma unroll
            for (int q = 0; q < 4; ++q) { v[q] = *(const f32x4*)(src + 4 * lane + 256 * q); s += (v[q][0] * v[q][0] + v[q][1] * v[q][1]) + (v[q][2] * v[q][2] + v[q][3] * v[q][3]); }
            const float rstd = 1.0f / sqrtf(wave_sum(s) * (1.0f / DM) + EPS);
#pragma unroll
            for (int q = 0; q < 4; ++q) { const int col = 4 * lane + 256 * q; const f32x4 g = *(const f32x4*)(g1 + col), sc = *(const f32x4*)(mb + 1024 + col), sh = *(const f32x4*)(mb + col);
                const f32x4 o = v[q] * rstd * g * (sc + 1.0f) + sh; u32x2 w; w.x = cvt_pk_bf16(o[0], o[1]); w.y = cvt_pk_bf16(o[2], o[3]);
                *(u32x2*)(Hb + (size_t)r * DM + col) = w; }
        }
    }
    SEAM(1);

    if (IN(2)) {
        pg8::Gemm g{Hb, WinT, DM, DM}; pg8::Order S; S.init(MEXT / 256, NWIN / 256, G, bx, 0);
        pg8::EpiY E{Yb, G8b, ssq_q, ssq_kv};
        pg8::gemm_phase(lds, g, S, E);
    }
    SEAM(2);

    if (IN(3)) {
#ifndef NO_P3A
        { pg8::Gemm g{Yb + Y_CQ, WuqT, YW, 384}; pg8::Order S; S.init(MLAT / 256, QW / 256, G, bx, 1);
          pg8::EpiQ E{Qb, ssq_q}; pg8::gemm_phase(lds, g, S, E); }
#endif
#ifndef NO_P3B
        { pg8::Gemm g{Yb + Y_CKV, WukvT, YW, 256}; pg8::Order S; S.init(MEXT / 256, 1024 / 256, G, bx, 0);
          pg8::EpiKV E{Kb, ssq_kv}; pg8::gemm_phase(lds, g, S, E); }
#endif
        const int gt = bx * 512 + tid, NTH = G * 512;
#ifndef NO_P3C
        for (int idx = gt; idx < MEXT * 4; idx += NTH) {
            const int r = idx >> 2, fq = idx & 3, b = r / EXT, j = r - b * EXT, part = fq >> 1, j0 = 4 * (fq & 1);
            const bf16_t* src = Yb + (size_t)r * YW + Y_KR + part * 16 + j0;
            const u32x2 a1 = *(const u32x2*)src, a2 = *(const u32x2*)(src + 8);
            f32x4 x1 = (f32x4){bf_lo(a1.x), bf_hi(a1.x), bf_lo(a1.y), bf_hi(a1.y)}, x2 = (f32x4){bf_lo(a2.x), bf_hi(a2.x), bf_lo(a2.y), bf_hi(a2.y)};
            if (j >= CTXL) { const int t = j - CTXL, pos = part ? (t & 63) : (t >> 6); const float* tp = tab + pos * 16 + j0 * 2;
                const f32x4 t0 = *(const f32x4*)tp, t1 = *(const f32x4*)(tp + 4);
                const f32x4 cs = (f32x4){t0[0], t0[2], t1[0], t1[2]}, sn = (f32x4){t0[1], t0[3], t1[1], t1[3]};
                const f32x4 o1 = x1 * cs - x2 * sn, o2 = x1 * sn + x2 * cs; x1 = o1; x2 = o2; }
            const u32x4 w = pack8(x1, x2);
#pragma unroll
            for (int h = 0; h < NH; ++h) *(u32x4*)(Kb + ((size_t)((b * NH + h) * (EXT / 64) + (j >> 6)) * 12 + 8 + fq) * 512 + (size_t)(j & 63) * 8) = w;
        }
#endif
#ifndef NO_P3D
        for (int idx = gt; idx < (MLAT / 32) * 64; idx += NTH) {
            const int seg = idx >> 6, ch = idx & 63, b = seg >> 8, t0 = (seg & 255) << 5, half = 1 << (ch >> 4);
            const bf16_t* base = Yb + (size_t)(b * EXT + CTXL) * YW + Y_POOL + ch * 8;
            bf16_t* dst = Dp + (size_t)(b * EXT + CTXL) * 512 + ch * 8;
            f32x4 s0 = (f32x4){0.f, 0.f, 0.f, 0.f}, s1 = s0;
            for (int sidx = max(t0 - half, 0); sidx < min(t0 + half, SEQ); ++sidx) { f32x4 p0, p1; unpack8(*(const u32x4*)(base + (size_t)sidx * YW), p0, p1); s0 += p0; s1 += p1; }
#pragma unroll 4
            for (int t = t0; t < t0 + 32; ++t) {
                const int cnt = min(t + half, SEQ) - max(t - half, 0); const float inv = 1.0f / (float)cnt;
                f32x4 c0, c1; unpack8(*(const u32x4*)(base + (size_t)t * YW), c0, c1);
                *(u32x4*)(dst + (size_t)t * 512) = pack8(s0 * inv - c0, s1 * inv - c1);
                if (t + half < SEQ) { f32x4 p0, p1; unpack8(*(const u32x4*)(base + (size_t)(t + half) * YW), p0, p1); s0 += p0; s1 += p1; }
                if (t - half >= 0) { f32x4 p0, p1; unpack8(*(const u32x4*)(base + (size_t)(t - half) * YW), p0, p1); s0 -= p0; s1 -= p1; }
            }
        }
#endif
    }
    SEAM(3);

    if (IN(4)) {
        const int xcd = bx & 7, loc = bx >> 3, per = G >> 3;
        for (int rep = 0; rep < REP4; ++rep)
        for (int i = 0; i < 8; ++i) {
            const int bh = xcd * 8 + i, b = bh >> 3, h = bh & 7;
            for (int qb = loc; qb < 32; qb += per) {
                const size_t krow0 = (size_t)b * EXT, qrow0 = krow0 + CTXL + (size_t)qb * 256;
                att::attn_unit((const att::bf16*)(Qb + qrow0 * QW + h * QKD), (const att::bf16*)(Kb + (size_t)bh * EXT * QKD), (const att::bf16*)(Vb + (size_t)bh * EXT * 64),
                               (att::bf16*)(At + qrow0 * VW + h * 64), EXT, (char*)lds_raw, tab, qb * 256);
            }
        }
    }
    SEAM(4);

    if (IN(5)) {
        { pg8::Gemm g{At, WbmT, 512, 512}; pg8::Order S; S.init(MLAT / 256, 4, G, bx, 1); pg8::EpiMerge<0> E{Mg, G8b}; pg8::gemm_phase(lds, g, S, E); }
        { pg8::Gemm g{Dp, WppT, 512, 512}; pg8::Order S; S.init(MLAT / 256, 4, G, bx, 1); pg8::EpiMerge<1> E{Mg, G8b}; pg8::gemm_phase(lds, g, S, E); }
    }
    SEAM(5);

    if (IN(6)) {
        pg8::Gemm g{Mg, WoutT, DM, DM}; pg8::Order S; S.init(MLAT / 256, 4, G, bx, 1);
        pg8::EpiOut E{a.in[0], X1b, X1s, mod, a.in[17], ssq2}; pg8::gemm_phase(lds, g, S, E);
    }
    SEAM(6);

    if (IN(7)) {
        pg8::Gemm g{X1s, W1T, DM, DM}; pg8::Order S; S.init(MLAT / 256, DFF / 256, G, bx, 1);
        pg8::EpiUp E{Ub, ssq2, bias2}; for (int rep = 0; rep < REP7; ++rep) pg8::gemm_phase(lds, g, S, E);
    }
    SEAM(7);

    if (IN(8)) {
        pg8::Gemm g{Ub, W2T, DFF, DFF, 1}; pg8::Order S; S.init(MLAT / 256, 4, G, bx, 1);
        pg8::EpiDown E{a.out, X1b, mod, a.in[20], (float*)(ws + WS_XBUF), (unsigned*)(ws + WS_XCNT), lds + 131072}; pg8::gemm_phase(lds, g, S, E);
    }
#undef IN
#undef SEAM
}

extern "C" void kernel_launch(void* const* d_in, const int* in_sizes, int n_in, void* d_out, int out_size, void* d_ws, size_t ws_size, hipStream_t stream) {
    static int grid = 0;
    if (grid == 0) {
        if (n_in != 21 || in_sizes[0] != MLAT * DM || out_size != MLAT * DM || ws_size < WS_END) {
            fprintf(stderr, "kernel_launch: shape mismatch n_in %d in0 %d out %d ws %zu (need %zu)\n", n_in, n_in > 0 ? in_sizes[0] : -1, out_size, ws_size, (size_t)WS_END); grid = -1; return; }
        int dev = 0, cus = 0, per_cu = 0;
        hipGetDevice(&dev); hipDeviceGetAttribute(&cus, hipDeviceAttributeMultiprocessorCount, dev);
        if (hipFuncSetAttribute((const void*)fwd, hipFuncAttributeMaxDynamicSharedMemorySize, LDS_BYTES) != hipSuccess) { fprintf(stderr, "kernel_launch: hipFuncSetAttribute failed\n"); grid = -1; return; }
        if (hipOccupancyMaxActiveBlocksPerMultiprocessor(&per_cu, (const void*)fwd, 512, LDS_BYTES) != hipSuccess || per_cu < 1) { fprintf(stderr, "kernel_launch: occupancy query says %d\n", per_cu); per_cu = 1; }
        (void)hipGetLastError();
        grid = cus;
        if (grid != 256) fprintf(stderr, "kernel_launch: note: %d CUs\n", grid);
    }
    if (grid < 0) return;
    hipMemsetAsync(d_ws, 0, ZERO_BYTES, stream);
    Args a{};
    for (int i = 0; i < 21; ++i) a.in[i] = (const float*)d_in[i];
    a.out = (float*)d_out; a.ws = (unsigned char*)d_ws;
#if MK_COOP
    a.ph_lo = 0; a.ph_hi = NPHASE;
    void* args[] = {&a};
    hipError_t e = hipLaunchCooperativeKernel((const void*)fwd, dim3(grid), dim3(512), args, LDS_BYTES, stream);
    if (e != hipSuccess) fprintf(stderr, "kernel_launch: cooperative launch failed: %s (grid %d)\n", hipGetErrorString(e), grid);
#else
    for (int p = 0; p < NPHASE; ++p) { a.ph_lo = p; a.ph_hi = p + 1; hipLaunchKernelGGL(fwd, dim3(grid), dim3(512), LDS_BYTES, stream, a); }
#endif
}
```

```cpp
#include <hip/hip_runtime.h>
#include <hip/hip_bf16.h>
#include <hip/hip_cooperative_groups.h>
#include <cstdio>
#include <cstdint>
namespace cg = cooperative_groups;

#ifndef REP4
#define REP4 1
#endif
#ifndef REP7
#define REP7 1
#endif
#ifndef REP2
#define REP2 1
#endif
#ifndef MK_COOP
#define MK_COOP 1
#endif

#define LAS __attribute__((address_space(3)))
typedef unsigned short bf16_t;
typedef short bf16x8 __attribute__((ext_vector_type(8)));
typedef short s16x4 __attribute__((ext_vector_type(4)));
typedef float f32x4 __attribute__((ext_vector_type(4)));
typedef float f32x2 __attribute__((ext_vector_type(2)));
typedef float f32x16 __attribute__((ext_vector_type(16)));
typedef unsigned u32x4 __attribute__((ext_vector_type(4)));
typedef unsigned u32x2 __attribute__((ext_vector_type(2)));

constexpr int DM = 1024, NB = 8, SEQ = 8192, CTXL = 256, EXT = SEQ + CTXL, MEXT = NB * EXT, MLAT = NB * SEQ;
constexpr int NH = 8, QKD = 96, QW = NH * QKD  , VW = 512, DFF = 4096;
constexpr int NWIN = 3328;
constexpr int YW = 1280;
constexpr int GW8 = 2048;
constexpr int Y_CQ = 0, Y_KR = 384, Y_CKV = 512, Y_POOL = 768, Y_GM = 1280, Y_GP = 2304;
constexpr float EPS = 1e-6f;
constexpr float QSCALE_LOG2E = 0.10206207261596575f * 1.4426950408889634f;
constexpr int NPHASE = 9;
constexpr int LDS_BYTES = 147456;

constexpr size_t KiB = 1024, MiB = 1024 * 1024;
constexpr size_t WS_R3_ = 296 * MiB;
constexpr size_t WS_MOD = 0, WS_BIAS2 = 256 * KiB, WS_SSQQ = 384 * KiB, WS_SSQKV = 656 * KiB, WS_SSQ2 = 928 * KiB, WS_SSQ3 = 1200 * KiB, ZERO_BYTES = 1536 * KiB;
constexpr size_t WS_BAR = 1472 * KiB;
constexpr size_t WS_XCNT = 1488 * KiB;
constexpr size_t WS_XBUF = WS_R3_;
constexpr size_t WS_TAB = 1536 * KiB;
constexpr size_t WS_WIN = 2 * MiB, WS_WUQ = 9 * MiB, WS_WUKV = 10 * MiB, WS_WBM = 11 * MiB, WS_WPP = 12 * MiB, WS_WOUT = 13 * MiB, WS_W1 = 15 * MiB, WS_W2 = 23 * MiB;
constexpr size_t WS_R1 = 32 * MiB;
constexpr size_t WS_H = WS_R1, WS_Q = WS_R1, WS_K = WS_R1 + 99 * MiB, WS_V = WS_R1 + 198 * MiB, WS_MERGED = WS_R1;
constexpr size_t WS_R3 = 296 * MiB;
constexpr size_t WS_DPOOL = WS_R3, WS_ATTN = WS_R3 + 66 * MiB, WS_X1S = WS_R3;
constexpr size_t WS_R2 = 428 * MiB;
constexpr size_t WS_Y = WS_R2, WS_G8 = WS_R2 + 166 * MiB, WS_U = WS_R2;
constexpr size_t WS_END = 956 * MiB;
static_assert((size_t)MEXT * 1024 * 2 == 132 * MiB && (size_t)MEXT * 768 * 2 == 99 * MiB && (size_t)MEXT * 512 * 2 == 66 * MiB, "sizes");
static_assert((size_t)MEXT * DFF * 2 == 528 * MiB && (size_t)MEXT * YW * 2 <= 166 * MiB && (size_t)MEXT * GW8 == 132 * MiB, "sizes");

struct Args { const float* in[21]; float* out; unsigned char* ws; int ph_lo, ph_hi; };

__device__ __forceinline__ unsigned cvt_pk_bf16(float lo, float hi) { unsigned r; asm volatile("v_cvt_pk_bf16_f32 %0, %1, %2" : "=v"(r) : "v"(lo), "v"(hi)); return r; }
__device__ __forceinline__ float bf_lo(unsigned w) { return __uint_as_float(w << 16); }
__device__ __forceinline__ float bf_hi(unsigned w) { return __uint_as_float(w & 0xffff0000u); }
__device__ __forceinline__ float wave_sum(float v) {
#pragma unroll
    for (int o = 1; o < 64; o <<= 1) v += __shfl_xor(v, o);
    return v;
}
__device__ __forceinline__ float sigmoidf_(float x) { return __builtin_amdgcn_rcpf(1.f + __expf(-x)); }
__device__ __forceinline__ u32x4 pack8(f32x4 a, f32x4 b) { u32x4 w; w.x = cvt_pk_bf16(a[0], a[1]); w.y = cvt_pk_bf16(a[2], a[3]); w.z = cvt_pk_bf16(b[0], b[1]); w.w = cvt_pk_bf16(b[2], b[3]); return w; }
__device__ __forceinline__ void unpack8(u32x4 w, f32x4& a, f32x4& b) { a = (f32x4){bf_lo(w.x), bf_hi(w.x), bf_lo(w.y), bf_hi(w.y)}; b = (f32x4){bf_lo(w.z), bf_hi(w.z), bf_lo(w.w), bf_hi(w.w)}; }

namespace pg8 {
constexpr int BM = 256, BK = 64, HALF = 128, HTB = HALF * BK * 2, STAGE_BYTES = 8 * HTB, NXCD = 8, WGM = 8;
__host__ __device__ __forceinline__ int lds_byte(int r, int c) { const int st = (r >> 4) * 2 + (c >> 5), rr = r & 15, cc = c & 31, ob = rr * 64 + cc * 2; return st * 1024 + (ob ^ (((ob >> 9) & 1) << 5)); }
__host__ __device__ __forceinline__ void stage_rc(int b, int& R, int& C) { const int st = b / 1024, sb = b % 1024, swz = sb ^ (((sb >> 9) & 1) << 5); R = (st >> 1) * 16 + swz / 64; C = (st & 1) * 32 + (swz % 64) / 2; }
__host__ __device__ __forceinline__ int perm32(int rho) { const int n = rho >> 4, i = rho & 15; return 8 * (i >> 2) + 4 * n + (i & 3); }

struct Unit { int pm, pn, rnd; };
struct Gemm { const bf16_t* A; const bf16_t* Bt; int lda, K, tiledA = 0; };

struct Order {
    int nM, nN, nwg, G, c, latent;
    __device__ void init(int nM_, int nN_, int G_, int c_, int latent_) { nM = nM_; nN = nN_; nwg = nM * nN; G = G_; c = c_; latent = latent_; }
    __device__ bool next(int i, Unit& u) const {
        const long L = (long)i * G + c; if (L >= nwg) return false;
        int wgid = (int)L; { const int q = nwg / NXCD, r = nwg % NXCD, xcd = wgid % NXCD, off = wgid / NXCD; wgid = (xcd < r ? xcd * (q + 1) : r * (q + 1) + (xcd - r) * q) + off; }
        const int nig = WGM * nN, gid = wgid / nig, fm = gid * WGM, gsz = (nM - fm) < WGM ? (nM - fm) : WGM;
        int pm = fm + ((wgid % nig) % gsz); u.pn = (wgid % nig) / gsz;
        u.pm = latent ? pm + (pm >> 5) + 1 : pm; u.rnd = i; return true;
    }
};

template <class Epi, class Sched>
__device__ __forceinline__ void gemm_phase(LAS unsigned char* lds, const Gemm g, const Sched& S, const Epi& E) {
    int tid_ = threadIdx.x; asm volatile("" : "+v"(tid_));
    const int tid = tid_, wid = __builtin_amdgcn_readfirstlane(tid >> 6), lane = tid & 63, wr = wid >> 2, wc = wid & 3, fr = lane & 15, fq = lane >> 4;
    const int K = g.K, nt = K / BK, lda = g.lda;
    unsigned voffA[2], voffB[2];
#pragma unroll
    for (int i = 0; i < 2; ++i) { int R, C; stage_rc(tid * 16 + i * 8192, R, C); const int Rb = (R & ~31) + perm32(R & 31);
        voffA[i] = g.tiledA ? (unsigned)(tid * 16 + i * 8192) : (unsigned)(R * lda + C) * 2u; voffB[i] = (unsigned)(Rb * K + C) * 2u; }
    const size_t kstep = (size_t)(BK * 2), kstepA = g.tiledA ? (size_t)HTB : kstep;
    const size_t hstepA = g.tiledA ? (size_t)(K / BK) * HTB : (size_t)HALF * lda * 2, hstepB = (size_t)HALF * K * 2;
    const size_t tstepA = 2 * hstepA, tstepB = 2 * hstepB;
    const unsigned ldsw = (unsigned)wid * 1024u;
    const int aoff = lds_byte(wr * 64 + fr, fq * 8), boff = lds_byte(wc * 32 + fr, fq * 8);
#define PG8_SA(b, h) (((b) * 2 + (h)) * HTB)
#define PG8_SB(b, h) ((4 + (b) * 2 + (h)) * HTB)
#define PG8_STAGE(bufoff, gbase, voff) do { _Pragma("unroll") for (int _i = 0; _i < 2; ++_i) \
        __builtin_amdgcn_global_load_lds((const unsigned*)((const char*)(gbase) + (voff)[_i]), (LAS unsigned*)(lds + (bufoff) + ldsw + _i * 8192), 16, 0, 0); } while (0)
#define PG8_LDA(dst, b, h) do { _Pragma("unroll") for (int m = 0; m < 4; ++m) _Pragma("unroll") for (int k = 0; k < 2; ++k) dst[m][k] = *(const LAS bf16x8*)(lds + PG8_SA(b, h) + aoff + m * 2048 + k * 1024); } while (0)
#define PG8_LDB(dst, b, h) do { _Pragma("unroll") for (int n = 0; n < 2; ++n) _Pragma("unroll") for (int k = 0; k < 2; ++k) dst[n][k] = *(const LAS bf16x8*)(lds + PG8_SB(b, h) + boff + n * 2048 + k * 1024); } while (0)
#define PG8_MMA(ai, bj, At, Bt) do { __builtin_amdgcn_s_setprio(1); _Pragma("unroll") for (int m = 0; m < 4; ++m) _Pragma("unroll") for (int n = 0; n < 2; ++n) _Pragma("unroll") for (int k = 0; k < 2; ++k) \
        acc[ai][bj][m][n] = __builtin_amdgcn_mfma_f32_16x16x32_bf16(Bt[n][k], At[m][k], acc[ai][bj][m][n], 0, 0, 0); __builtin_amdgcn_s_setprio(0); } while (0)
#define PG8_WAIT_V(n) asm volatile("s_waitcnt vmcnt(" #n ")" ::: "memory")
#define PG8_WAIT_L(n) asm volatile("s_waitcnt lgkmcnt(" #n ")" ::: "memory")
#define PG8_BAR __builtin_amdgcn_s_barrier()
#define PG8_SCHED __builtin_amdgcn_sched_barrier(0)
    Unit cur, nxt; int ui = 0;
    if (!S.next(0, cur)) return;
    f32x4 acc[2][2][4][2];
#pragma unroll
    for (int a = 0; a < 2; ++a)
#pragma unroll
        for (int b = 0; b < 2; ++b)
#pragma unroll
            for (int m = 0; m < 4; ++m)
#pragma unroll
                for (int n = 0; n < 2; ++n) acc[a][b][m][n] = (f32x4){0.f, 0.f, 0.f, 0.f};
    bf16x8 At[4][2], B0[2][2], B1[2][2];
    const char* cA = (const char*)g.A + (size_t)cur.pm * tstepA; const char* cB = (const char*)g.Bt + (size_t)cur.pn * tstepB;
    PG8_STAGE(PG8_SB(0, 0), cB, voffB); PG8_STAGE(PG8_SB(0, 1), cB + hstepB, voffB); PG8_STAGE(PG8_SA(0, 0), cA, voffA); PG8_STAGE(PG8_SA(0, 1), cA + hstepA, voffA);
    if (wr == 1) PG8_BAR;
    PG8_WAIT_V(2); PG8_BAR;
    PG8_STAGE(PG8_SB(1, 0), cB + kstep, voffB); PG8_STAGE(PG8_SA(1, 0), cA + kstepA, voffA); PG8_STAGE(PG8_SB(1, 1), cB + hstepB + kstep, voffB);
    PG8_WAIT_V(6); PG8_BAR;
    for (;;) {
        const bool has_next = S.next(ui + 1, nxt);
        const char* nA = has_next ? (const char*)g.A + (size_t)nxt.pm * tstepA : cA; const char* nB = has_next ? (const char*)g.Bt + (size_t)nxt.pn * tstepB : cB;
#pragma unroll 1
        for (int t = 0; t < nt; t += 2) {
            const bool last = (t == nt - 2);
            const char* a1 = cA + (size_t)(t + 1) * kstepA;
            const char* a2 = last ? nA : cA + (size_t)(t + 2) * kstepA; const char* b2 = last ? nB : cB + (size_t)(t + 2) * kstep;
            const char* a3 = a2 + kstepA; const char* b3 = b2 + kstep;
            PG8_LDB(B0, 0, 0); PG8_LDB(B1, 0, 1); PG8_SCHED; PG8_LDA(At, 0, 0); PG8_STAGE(PG8_SA(1, 1), a1 + hstepA, voffA);
            PG8_WAIT_V(8); PG8_WAIT_L(0); PG8_BAR; PG8_MMA(0, 0, At, B0); PG8_MMA(0, 1, At, B1); PG8_BAR; PG8_SCHED;
            PG8_LDA(At, 0, 1); PG8_STAGE(PG8_SB(0, 0), b2, voffB); PG8_STAGE(PG8_SB(0, 1), b2 + hstepB, voffB); PG8_STAGE(PG8_SA(0, 0), a2, voffA);
            PG8_WAIT_V(8); PG8_WAIT_L(0); PG8_BAR; PG8_MMA(1, 0, At, B0); PG8_MMA(1, 1, At, B1); PG8_BAR; PG8_SCHED;
            PG8_LDB(B0, 1, 0); PG8_LDB(B1, 1, 1); PG8_SCHED; PG8_LDA(At, 1, 0); PG8_STAGE(PG8_SA(0, 1), a2 + hstepA, voffA);
            PG8_WAIT_V(8); PG8_WAIT_L(0); PG8_BAR; PG8_MMA(0, 0, At, B0); PG8_MMA(0, 1, At, B1); PG8_BAR; PG8_SCHED;
            PG8_LDA(At, 1, 1); PG8_STAGE(PG8_SB(1, 0), b3, voffB); PG8_STAGE(PG8_SB(1, 1), b3 + hstepB, voffB); PG8_STAGE(PG8_SA(1, 0), a3, voffA);
            PG8_WAIT_V(8); PG8_WAIT_L(0); PG8_BAR; PG8_MMA(1, 0, At, B0); PG8_MMA(1, 1, At, B1); PG8_BAR; PG8_SCHED;
        }
        if (wr == 0) PG8_BAR;
        E(acc, cur, wr, wc, fr, fq);
        if (!has_next) break;
#pragma unroll
        for (int a = 0; a < 2; ++a)
#pragma unroll
            for (int b = 0; b < 2; ++b)
#pragma unroll
                for (int m = 0; m < 4; ++m)
#pragma unroll
                    for (int n = 0; n < 2; ++n) acc[a][b][m][n] = (f32x4){0.f, 0.f, 0.f, 0.f};
        cur = nxt; cA = nA; cB = nB; ++ui;
        if (wr == 1) PG8_BAR;
    }
    PG8_WAIT_V(0);
    PG8_BAR;
#undef PG8_SA
#undef PG8_SB
#undef PG8_STAGE
#undef PG8_LDA
#undef PG8_LDB
#undef PG8_MMA
#undef PG8_WAIT_V
#undef PG8_WAIT_L
#undef PG8_BAR
#undef PG8_SCHED
}

typedef f32x4 (&AccRef)[2][2][4][2];
#define EPI_ROWS(u) const int row0_ = (u).pm * BM + wr * 64 + fr; const int colb_ = (u).pn * BM + wc * 32 + 8 * fq;
#define EPI_ROW(ai, m) (row0_ + (ai) * HALF + (m) * 16)
#define EPI_COL(bj) (colb_ + (bj) * HALF)

struct EpiY { bf16_t* Y; unsigned char* G8; float* ssq_q; float* ssq_kv;
    __device__ __forceinline__ void operator()(AccRef acc, const Unit& u, int wr, int wc, int fr, int fq) const {
        EPI_ROWS(u)
        if (u.pn >= 5) {
#pragma unroll
            for (int ai = 0; ai < 2; ++ai)
#pragma unroll
                for (int m = 0; m < 4; ++m) { const int row = EPI_ROW(ai, m);
#pragma unroll
                    for (int bj = 0; bj < 2; ++bj) { const f32x4 v0 = acc[ai][bj][m][0], v1 = acc[ai][bj][m][1]; unsigned q[8];
#pragma unroll
                        for (int i = 0; i < 4; ++i) { q[i] = (unsigned)(sigmoidf_(v0[i]) * 255.f + 0.5f); q[4 + i] = (unsigned)(sigmoidf_(v1[i]) * 255.f + 0.5f); }
                        u32x2 w; w.x = q[0] | (q[1] << 8) | (q[2] << 16) | (q[3] << 24); w.y = q[4] | (q[5] << 8) | (q[6] << 16) | (q[7] << 24);
                        *(u32x2*)(G8 + (size_t)row * GW8 + (EPI_COL(bj) - 1280)) = w; } }
            return; }
        const int mode = (u.pn == 0) ? 1 : (u.pn == 1 ? 2 : (u.pn == 2 ? 3 : 0));
#pragma unroll
        for (int ai = 0; ai < 2; ++ai)
#pragma unroll
            for (int m = 0; m < 4; ++m) { const int row = EPI_ROW(ai, m); float s = 0.f;
#pragma unroll
                for (int bj = 0; bj < 2; ++bj) { const f32x4 v0 = acc[ai][bj][m][0], v1 = acc[ai][bj][m][1];
                    *(u32x4*)(Y + (size_t)row * YW + EPI_COL(bj)) = pack8(v0, v1);
                    if (mode == 1 || mode == 3 || (mode == 2 && bj == 0)) s += (v0[0] * v0[0] + v0[1] * v0[1]) + (v0[2] * v0[2] + v0[3] * v0[3]) + (v1[0] * v1[0] + v1[1] * v1[1]) + (v1[2] * v1[2] + v1[3] * v1[3]); }
                if (mode) { s += __shfl_xor(s, 16); s += __shfl_xor(s, 32); if (fq == 0) unsafeAtomicAdd((mode == 3 ? ssq_kv : ssq_q) + row, s); } }
    }
};
struct EpiQ { bf16_t* Q; const float* ssq_q;
    __device__ __forceinline__ void operator()(AccRef acc, const Unit& u, int wr, int wc, int fr, int fq) const {
        EPI_ROWS(u)
#pragma unroll
        for (int ai = 0; ai < 2; ++ai)
#pragma unroll
            for (int m = 0; m < 4; ++m) { const int row = EPI_ROW(ai, m); const float rstd = QSCALE_LOG2E / sqrtf(ssq_q[row] * (1.0f / 384.0f) + EPS);
#pragma unroll
                for (int bj = 0; bj < 2; ++bj) *(u32x4*)(Q + (size_t)row * QW + EPI_COL(bj)) = pack8(acc[ai][bj][m][0] * rstd, acc[ai][bj][m][1] * rstd); }
    }
};
struct EpiKV { bf16_t* Kb; const float* ssq_kv;
    __device__ __forceinline__ void operator()(AccRef acc, const Unit& u, int wr, int wc, int fr, int fq) const {
        EPI_ROWS(u)
        const int bt = u.pm / 33;
#pragma unroll
        for (int ai = 0; ai < 2; ++ai)
#pragma unroll
            for (int m = 0; m < 4; ++m) { const int row = EPI_ROW(ai, m); const float rstd = 1.0f / sqrtf(ssq_kv[row] * (1.0f / 256.0f) + EPS);
#pragma unroll
                for (int bj = 0; bj < 2; ++bj) { const f32x4 v0 = acc[ai][bj][m][0] * rstd, v1 = acc[ai][bj][m][1] * rstd; const int col = EPI_COL(bj);
                    const int hh = (col >> 6) & 7, dd = col & 63; const size_t hk = (size_t)((bt * NH + hh) * EXT + (row - bt * EXT));
                    const int key_ = row - bt * EXT;
                    const size_t koff_ = ((size_t)((bt * NH + hh) * (EXT / 64) + (key_ >> 6)) * 12 + (dd >> 3)) * 512 + (size_t)(key_ & 63) * 8;
                    const size_t off = (col < 512) ? koff_ : (size_t)((WS_V - WS_K) / 2) + hk * 64 + dd;
                    *(u32x4*)(Kb + off) = pack8(v0, v1); } }
    }
};
template <int SECOND> struct EpiMerge { bf16_t* Mg; const unsigned char* G8;
    __device__ __forceinline__ void operator()(AccRef acc, const Unit& u, int wr, int wc, int fr, int fq) const {
        EPI_ROWS(u)
#pragma unroll
        for (int ai = 0; ai < 2; ++ai)
#pragma unroll
            for (int m = 0; m < 4; ++m) { const int row = EPI_ROW(ai, m);
#pragma unroll
                for (int bj = 0; bj < 2; ++bj) { const int col = EPI_COL(bj); const u32x2 gq = *(const u32x2*)(G8 + (size_t)row * GW8 + (SECOND ? 1024 : 0) + col);
                    f32x4 v0 = acc[ai][bj][m][0], v1 = acc[ai][bj][m][1];
#pragma unroll
                    for (int i = 0; i < 4; ++i) { v0[i] *= (float)((gq.x >> (8 * i)) & 255u) * (1.0f / 255.0f); v1[i] *= (float)((gq.y >> (8 * i)) & 255u) * (1.0f / 255.0f); }
                    bf16_t* dst = Mg + (size_t)row * DM + col;
                    if (SECOND) { f32x4 p0, p1; unpack8(*(const u32x4*)dst, p0, p1); v0 += p0; v1 += p1; }
                    *(u32x4*)dst = pack8(v0, v1); } }
    }
};
struct EpiOut { const float* x; bf16_t* x1b; bf16_t* x1s; const float* mod; const float* g2; float* ssq2;
    __device__ __forceinline__ void operator()(AccRef acc, const Unit& u, int wr, int wc, int fr, int fq) const {
        EPI_ROWS(u)
        const int bt = u.pm / 33; const float* mb = mod + bt * 6144;
        f32x4 gt[2][2], sc[2][2];
#pragma unroll
        for (int bj = 0; bj < 2; ++bj)
#pragma unroll
            for (int n = 0; n < 2; ++n) { const int col = EPI_COL(bj) + 4 * n; gt[bj][n] = *(const f32x4*)(mb + 2048 + col);
                const f32x4 g = *(const f32x4*)(g2 + col), s2 = *(const f32x4*)(mb + 4096 + col); sc[bj][n] = g * (s2 + 1.0f); }
#pragma unroll
        for (int ai = 0; ai < 2; ++ai)
#pragma unroll
            for (int m = 0; m < 4; ++m) { const int row = EPI_ROW(ai, m); const size_t lat = (size_t)(row - CTXL * (bt + 1)); float s = 0.f;
#pragma unroll
                for (int bj = 0; bj < 2; ++bj) { const int col = EPI_COL(bj); const size_t off = lat * DM + col;
                    const f32x4 x0 = *(const f32x4*)(x + off), x1 = *(const f32x4*)(x + off + 4);
                    const f32x4 v0 = x0 + gt[bj][0] * acc[ai][bj][m][0], v1 = x1 + gt[bj][1] * acc[ai][bj][m][1];
                    *(u32x4*)(x1b + (size_t)row * DM + col) = pack8(v0, v1);
                    s += (v0[0] * v0[0] + v0[1] * v0[1]) + (v0[2] * v0[2] + v0[3] * v0[3]) + (v1[0] * v1[0] + v1[1] * v1[1]) + (v1[2] * v1[2] + v1[3] * v1[3]);
                    *(u32x4*)((char*)x1s + ((size_t)(row >> 7) * (DM / 64) + (col >> 6)) * HTB + lds_byte(row & 127, col & 63)) = pack8(v0 * sc[bj][0], v1 * sc[bj][1]); }
                s += __shfl_xor(s, 16); s += __shfl_xor(s, 32); if (fq == 0) unsafeAtomicAdd(ssq2 + row, s); }
    }
};
struct EpiUp { bf16_t* U; const float* ssq2; const float* bias2;
    __device__ __forceinline__ void operator()(AccRef acc, const Unit& u, int wr, int wc, int fr, int fq) const {
        EPI_ROWS(u)
        const int bt = u.pm / 33; f32x4 bs[2][2];
#pragma unroll
        for (int bj = 0; bj < 2; ++bj)
#pragma unroll
            for (int n = 0; n < 2; ++n) bs[bj][n] = *(const f32x4*)(bias2 + bt * DFF + EPI_COL(bj) + 4 * n);
#pragma unroll
        for (int ai = 0; ai < 2; ++ai)
#pragma unroll
            for (int m = 0; m < 4; ++m) { const int row = EPI_ROW(ai, m); const float rstd = 1.0f / sqrtf(ssq2[row] * (1.0f / 1024.0f) + EPS);
#pragma unroll
                for (int bj = 0; bj < 2; ++bj) { f32x4 v0 = acc[ai][bj][m][0] * rstd + bs[bj][0], v1 = acc[ai][bj][m][1] * rstd + bs[bj][1];
#pragma unroll
                    for (int i = 0; i < 4; ++i) { const float a = fmaxf(v0[i], 0.f), b = fmaxf(v1[i], 0.f); v0[i] = a * a; v1[i] = b * b; }
                    { const int c_ = EPI_COL(bj);
                      *(u32x4*)((char*)U + ((size_t)(row >> 7) * (DFF / 64) + (c_ >> 6)) * HTB + lds_byte(row & 127, c_ & 63)) = pack8(v0, v1); } } }
    }
};
struct EpiDown { float* out; const bf16_t* x1b; const float* mod; const float* fg; float* xbuf; unsigned* cnt; LAS unsigned char* lx;
    __device__ __forceinline__ void operator()(AccRef acc, const Unit& u, int wr, int wc, int fr, int fq) const {
        EPI_ROWS(u)
        const int bt = u.pm / 33; const float* mb = mod + bt * 6144;
        const int tid = threadIdx.x, wid = __builtin_amdgcn_readfirstlane(tid >> 6), lane = tid & 63;
        LAS float* P = (LAS float*)lx; LAS float* S = (LAS float*)(lx + 4096); volatile LAS unsigned* flag = (volatile LAS unsigned*)(lx + 5120);
        {   f32x4 gt[2][2];
#pragma unroll
            for (int bj = 0; bj < 2; ++bj)
#pragma unroll
                for (int n = 0; n < 2; ++n) gt[bj][n] = *(const f32x4*)(mb + 5120 + EPI_COL(bj) + 4 * n);
#pragma unroll
            for (int ai = 0; ai < 2; ++ai)
#pragma unroll
                for (int m = 0; m < 4; ++m) { const int row = EPI_ROW(ai, m); const size_t lat = (size_t)(row - CTXL * (bt + 1)); float s = 0.f;
#pragma unroll
                    for (int bj = 0; bj < 2; ++bj) { const size_t off = lat * DM + EPI_COL(bj);
                        f32x4 x0, x1; unpack8(*(const u32x4*)(x1b + (size_t)row * DM + EPI_COL(bj)), x0, x1);
                        const f32x4 v0 = x0 + gt[bj][0] * acc[ai][bj][m][0], v1 = x1 + gt[bj][1] * acc[ai][bj][m][1];
                        s += (v0[0] * v0[0] + v0[1] * v0[1]) + (v0[2] * v0[2] + v0[3] * v0[3]) + (v1[0] * v1[0] + v1[1] * v1[1]) + (v1[2] * v1[2] + v1[3] * v1[3]);
                        acc[ai][bj][m][0] = v0; acc[ai][bj][m][1] = v1; }
                    s += __shfl_xor(s, 16); s += __shfl_xor(s, 32);
                    if (fq == 0) P[(ai * HALF + wr * 64 + m * 16 + fr) * 4 + wc] = s;
                    asm volatile("" ::: "memory"); }
        }
        asm volatile("s_waitcnt lgkmcnt(0)" ::: "memory"); __builtin_amdgcn_s_barrier(); asm volatile("" ::: "memory");
        float* slot = xbuf + ((size_t)(u.rnd * (MEXT / 256) + u.pm) * 256) * 4;
        unsigned* cw = cnt + u.rnd * (MEXT / 256) + u.pm;
        if (tid < 256) { const float t4 = (P[tid * 4 + 0] + P[tid * 4 + 1]) + (P[tid * 4 + 2] + P[tid * 4 + 3]);
            __hip_atomic_store(slot + tid * 4 + u.pn, t4, __ATOMIC_RELAXED, __HIP_MEMORY_SCOPE_AGENT);
            asm volatile("s_waitcnt vmcnt(0)" ::: "memory");
            if (lane == 0) __hip_atomic_fetch_add(cw, 1u, __ATOMIC_RELAXED, __HIP_MEMORY_SCOPE_AGENT); }
        if (wid == 0) {
            unsigned sp = 0; bool dead = false;
            for (;;) { if ((unsigned)__builtin_amdgcn_readfirstlane(__hip_atomic_load(cw, __ATOMIC_RELAXED, __HIP_MEMORY_SCOPE_AGENT)) >= 16u) break;
                if (++sp > (1u << 22)) { dead = true; break; } __builtin_amdgcn_s_sleep(2); }
            __builtin_amdgcn_fence(__ATOMIC_ACQUIRE, "agent");
            if (lane == 0) flag[0] = dead ? 1u : 0u;
        }
        asm volatile("s_waitcnt vmcnt(0) lgkmcnt(0)" ::: "memory"); __builtin_amdgcn_s_barrier(); asm volatile("" ::: "memory");
        const bool bad = flag[0] != 0u;
        if (tid < 256) { float t4 = 0.f;
#pragma unroll
            for (int t = 0; t < 4; ++t) t4 += __hip_atomic_load(slot + tid * 4 + t, __ATOMIC_RELAXED, __HIP_MEMORY_SCOPE_AGENT);
            S[tid] = bad ? __builtin_nanf("") : 1.0f / sqrtf(t4 * (1.0f / DM) + EPS); }
        asm volatile("s_waitcnt vmcnt(0) lgkmcnt(0)" ::: "memory"); __builtin_amdgcn_s_barrier(); asm volatile("" ::: "memory");
        {   f32x4 fgv[2][2];
#pragma unroll
            for (int bj = 0; bj < 2; ++bj)
#pragma unroll
                for (int n = 0; n < 2; ++n) fgv[bj][n] = *(const f32x4*)(fg + EPI_COL(bj) + 4 * n);
#pragma unroll
            for (int ai = 0; ai < 2; ++ai)
#pragma unroll
                for (int m = 0; m < 4; ++m) { const int rl = ai * HALF + wr * 64 + m * 16 + fr; const float rs = S[rl]; const size_t lat = (size_t)(EPI_ROW(ai, m) - CTXL * (bt + 1));
#pragma unroll
                    for (int bj = 0; bj < 2; ++bj) { const size_t off = lat * DM + EPI_COL(bj);
                        *(f32x4*)(out + off) = acc[ai][bj][m][0] * rs * fgv[bj][0]; *(f32x4*)(out + off + 4) = acc[ai][bj][m][1] * rs * fgv[bj][1]; } }
        }
        asm volatile("s_waitcnt lgkmcnt(0)" ::: "memory"); __builtin_amdgcn_s_barrier(); asm volatile("" ::: "memory");
    }
};
}

namespace att {
using bf16 = __hip_bfloat16;
constexpr int NW = 8, QBLK = 32, KVBLK = 64;
constexpr float SCALE = 0.10206207261596575f;
constexpr float THR = 8.f;
constexpr int LDQ = QW, LDK = QKD, LDV = 64, LDO = VW;
constexpr int NSLOT = 3, KSLOT = 12288, VSLOT = 8192;
constexpr int LDS_K = 0, LDS_V = NSLOT * KSLOT, LDS_WS = LDS_V + NSLOT * VSLOT, SHM_ATTN = LDS_WS + NW * 64 * 4;
#define SBAR() __builtin_amdgcn_sched_barrier(0)
__device__ __forceinline__ int crow(int r, int hi) { return (r & 3) + 8 * (r >> 2) + 4 * hi; }
__device__ __forceinline__ unsigned cvtpk(float lo, float hi) { unsigned r; asm volatile("v_cvt_pk_bf16_f32 %0, %1, %2" : "=v"(r) : "v"(lo), "v"(hi)); return r; }
__device__ __forceinline__ bf16x8 ld8(const bf16* p) { return *reinterpret_cast<const bf16x8*>(p); }
__device__ __forceinline__ void glds16(const void* gsrc, unsigned lds_dst) { unsigned keep;
  asm volatile("s_mov_b32 %0, m0\n\ts_mov_b32 m0, %2\n\ts_nop 0\n\tglobal_load_lds_dwordx4 %1, off\n\ts_mov_b32 m0, %0" : "=&s"(keep) : "v"(gsrc), "s"(lds_dst) : "memory"); }

__device__ __forceinline__ void glds16s(unsigned voff, const void* sbase, unsigned lds_dst) { unsigned keep;
  asm volatile("s_mov_b32 %0, m0\n\ts_mov_b32 m0, %3\n\ts_nop 0\n\tglobal_load_lds_dwordx4 %1, %2\n\ts_mov_b32 m0, %0" : "=&s"(keep) : "v"(voff), "s"(sbase), "s"(lds_dst) : "memory"); }
__device__ __forceinline__ float rowmax32(const f32x16& p0, const f32x16& p1) {
  float pmax = p0[0];
#pragma unroll
  for (int r = 1; r < 16; ++r) pmax = fmaxf(pmax, p0[r]);
#pragma unroll
  for (int r = 0; r < 16; ++r) pmax = fmaxf(pmax, p1[r]);
  auto rr = __builtin_amdgcn_permlane32_swap(__float_as_uint(pmax), __float_as_uint(pmax), false, false);
  return fmaxf(__uint_as_float(rr[0]), __uint_as_float(rr[1]));
}
constexpr float THR2 = THR * 1.4426950408889634f;
__device__ __forceinline__ void decide(const f32x16& p0, const f32x16& p1, float& mhat, f32x16& negm, float& alpha) {
  const float pmax = rowmax32(p0, p1);
  if (__builtin_expect(__all(pmax <= THR2), 1)) { alpha = 1.f; }
  else { const float dl = fmaxf(pmax, 0.f); mhat += dl;
#pragma unroll
    for (int r = 0; r < 16; ++r) negm[r] = -mhat;
    alpha = __builtin_amdgcn_exp2f(-dl); }
}
__device__ __forceinline__ void guard(float ps, float& mhat, f32x16& negm, float& alpha) {
  constexpr float BIG = 1073741824.f;
  if (__builtin_expect(__all(ps <= BIG), 1)) { alpha = 1.f; }
  else { mhat += 30.f;
#pragma unroll
    for (int r = 0; r < 16; ++r) negm[r] = -mhat;
    alpha = 9.313225746154785e-10f; }
}
__device__ __forceinline__ void exps32(f32x16& p0, f32x16& p1) {
#pragma unroll
  for (int r = 0; r < 16; ++r) p0[r] = __builtin_amdgcn_exp2f(p0[r]);
#pragma unroll
  for (int r = 0; r < 16; ++r) p1[r] = __builtin_amdgcn_exp2f(p1[r]);
}
__device__ __forceinline__ void finishP(const f32x16& p0, const f32x16& p1, float alpha, float& l_reg, bf16x8& pa0, bf16x8& pa1, bf16x8& pa2, bf16x8& pa3, float& ps_out) {
  float ps = 0, ps2 = 0;
#pragma unroll
  for (int r = 0; r < 16; ++r) ps += p0[r];
#pragma unroll
  for (int r = 0; r < 16; ++r) ps2 += p1[r];
  ps += ps2;
  l_reg = (l_reg + ps) * alpha; ps_out = ps;
#define PK4(P, BASE, OUT) do { unsigned a0 = cvtpk(P[BASE + 0], P[BASE + 1]), a1 = cvtpk(P[BASE + 2], P[BASE + 3]);   \
    unsigned b0 = cvtpk(P[BASE + 4], P[BASE + 5]), b1 = cvtpk(P[BASE + 6], P[BASE + 7]);                              \
    u32x4 w = {a0, a1, b0, b1}; OUT = *reinterpret_cast<bf16x8*>(&w); } while (0)
  PK4(p0, 0, pa0); PK4(p0, 8, pa1); PK4(p1, 0, pa2); PK4(p1, 8, pa3);
#undef PK4
}
__device__ __forceinline__ void qkt(f32x16& p0, f32x16& p1, const char* Ks, const bf16x8* qr, const f32x16& negm) {
#pragma unroll
  for (int d0 = 0; d0 < 6; ++d0) {
    bf16x8 b0 = *reinterpret_cast<const bf16x8*>(Ks + d0 * 2048);
    bf16x8 b1 = *reinterpret_cast<const bf16x8*>(Ks + d0 * 2048 + 512);
    if (d0 == 0) { p0 = __builtin_amdgcn_mfma_f32_32x32x16_bf16(b0, qr[0], negm, 0, 0, 0); p1 = __builtin_amdgcn_mfma_f32_32x32x16_bf16(b1, qr[0], negm, 0, 0, 0); }
    else { p0 = __builtin_amdgcn_mfma_f32_32x32x16_bf16(b0, qr[d0], p0, 0, 0, 0); p1 = __builtin_amdgcn_mfma_f32_32x32x16_bf16(b1, qr[d0], p1, 0, 0, 0); } }
}
__device__ __forceinline__ int v_rd_base(int lane) { return ((lane & 3) << 3) | (((lane >> 2) & 3) << 6) | (((lane >> 4) & 1) << 5) | (((lane >> 5) & 1) << 8); }
constexpr int v_rd_off(int d0, int ks, int half) { return d0 * 512 + ks * 2048 + half * 1024; }
template <int OFF> __device__ __forceinline__ s16x4 tr_read(int vb) {
  s16x4 r; asm volatile("ds_read_b64_tr_b16 %0, %1 offset:%2" : "=&v"(r) : "v"(vb), "i"(OFF) : "memory"); return r;
}
struct VF { s16x4 l[2][4], h[2][4]; };
__device__ __forceinline__ void v_read(VF& f, int vb) {
#define VR(D0, KS) f.l[D0][KS] = tr_read<v_rd_off(D0, KS, 0)>(vb); f.h[D0][KS] = tr_read<v_rd_off(D0, KS, 1)>(vb);
  VR(0, 0) VR(0, 1) VR(0, 2) VR(0, 3) VR(1, 0) VR(1, 1) VR(1, 2) VR(1, 3)
#undef VR
}
__device__ __forceinline__ void v_wait(VF& f) {
  asm volatile("s_waitcnt lgkmcnt(0)" : "+v"(f.l[0][0]), "+v"(f.l[0][1]), "+v"(f.l[0][2]), "+v"(f.l[0][3]), "+v"(f.h[0][0]), "+v"(f.h[0][1]), "+v"(f.h[0][2]), "+v"(f.h[0][3]),
               "+v"(f.l[1][0]), "+v"(f.l[1][1]), "+v"(f.l[1][2]), "+v"(f.l[1][3]), "+v"(f.h[1][0]), "+v"(f.h[1][1]), "+v"(f.h[1][2]), "+v"(f.h[1][3]) :: "memory");
}
__device__ __forceinline__ void pv_mma(f32x16* o, const VF& f, bf16x8 pa0, bf16x8 pa1, bf16x8 pa2, bf16x8 pa3) {
#define PK(L, H) (bf16x8){L[0], L[1], L[2], L[3], H[0], H[1], H[2], H[3]}
#pragma unroll
  for (int d = 0; d < 2; ++d) {
    o[d] = __builtin_amdgcn_mfma_f32_32x32x16_bf16(pa0, PK(f.l[d][0], f.h[d][0]), o[d], 0, 0, 0);
    o[d] = __builtin_amdgcn_mfma_f32_32x32x16_bf16(pa1, PK(f.l[d][1], f.h[d][1]), o[d], 0, 0, 0);
    o[d] = __builtin_amdgcn_mfma_f32_32x32x16_bf16(pa2, PK(f.l[d][2], f.h[d][2]), o[d], 0, 0, 0);
    o[d] = __builtin_amdgcn_mfma_f32_32x32x16_bf16(pa3, PK(f.l[d][3], f.h[d][3]), o[d], 0, 0, 0); }
#undef PK
}

__device__ __forceinline__ void attn_unit(const bf16* __restrict__ Qb, const bf16* __restrict__ Kh, const bf16* __restrict__ Vh, bf16* __restrict__ Ob, int seq, char* lds, const float* __restrict__ tab, int t0) {
  int tid_ = threadIdx.x; asm volatile("" : "+v"(tid_));
  const int tid = tid_, lane = tid & 63, r32 = lane & 31, hi = lane >> 5; const int wid = __builtin_amdgcn_readfirstlane(tid >> 6);
  const unsigned lds0 = (unsigned)(uintptr_t)lds;
  float* ws = (float*)(lds + LDS_WS) + wid * 64; float* li_l = ws; float* al_l = ws + 32;
  float mhat = 0.f, l_reg = 0; f32x16 o[2] = {}; bf16x8 qr[6]; f32x16 negm = f32x16{}; asm volatile("" : "+v"(negm));
  const bf16* Qw = Qb + (long)(wid * QBLK + r32) * LDQ + hi * 8;
#pragma unroll
  for (int d0 = 0; d0 < 6; ++d0) qr[d0] = ld8(Qw + d0 * 16);
  { const int tq = t0 + wid * QBLK + r32;
#pragma unroll
    for (int part = 0; part < 2; ++part) { const int pos = part ? (tq & 63) : (tq >> 6); const float* tp = tab + pos * 16 + hi * 8;
      const f32x4 c0 = *(const f32x4*)tp, c1 = *(const f32x4*)(tp + 4);
      const f32x4 cs = (f32x4){c0[0], c0[2], c1[0], c1[2]}, sn = (f32x4){c0[1], c0[3], c1[1], c1[3]};
      const u32x4 w = __builtin_bit_cast(u32x4, qr[4 + part]); f32x4 x1, x2; unpack8(w, x1, x2);
      qr[4 + part] = __builtin_bit_cast(bf16x8, pack8(x1 * cs - x2 * sn, x1 * sn + x2 * cs)); } }
  const bool k2 = wid < 4;
  const unsigned koffA = (unsigned)(wid * 512 + lane * 8) * 2u, koffB = (unsigned)((8 + (wid & 3)) * 512 + lane * 8) * 2u;
  const int vkk = wid * 8 + ((lane >> 2) & 7), vkey = vkk;
  const unsigned voffV = (unsigned)(vkey * LDV + (lane >> 5) * 32 + (lane & 3) * 8) * 2u;
  const unsigned kdstA = lds0 + LDS_K + wid * 1024, kdstB = lds0 + LDS_K + (8 + (wid & 3)) * 1024, vdst = lds0 + LDS_V + wid * 1024;
#define DMA_K(t, slot) do { const bf16* kb_ = Kh + (long)(t) * KVBLK * LDK; glds16s(koffA, kb_, (unsigned)__builtin_amdgcn_readfirstlane(kdstA + (slot) * KSLOT)); \
    if (k2) glds16s(koffB, kb_, (unsigned)__builtin_amdgcn_readfirstlane(kdstB + (slot) * KSLOT)); } while (0)
#define DMA_V(t, slot) glds16s(voffV, Vh + (long)(t) * KVBLK * LDV, (unsigned)__builtin_amdgcn_readfirstlane(vdst + (slot) * VSLOT))
#define WAIT_ALL_BAR() asm volatile("s_waitcnt vmcnt(0) lgkmcnt(0)\n\ts_barrier" ::: "memory")
#define WAIT_STEP_BAR() do { if (k2) asm volatile("s_waitcnt vmcnt(3) lgkmcnt(0)\n\ts_barrier" ::: "memory"); else asm volatile("s_waitcnt vmcnt(2) lgkmcnt(0)\n\ts_barrier" ::: "memory"); } while (0)
#define RESC(a) do { if (__any((a) < 1.f)) { \
    _Pragma("unroll") for (int d = 0; d < 2; ++d) _Pragma("unroll") for (int r = 0; r < 16; ++r) o[d][r] *= (a); } } while (0)
  const char* kp0 = lds + LDS_K + hi * 1024 + r32 * 16;
  const int vb0 = (int)(lds0 + LDS_V) + v_rd_base(lane);
  f32x16 pA0, pA1, pB0, pB1; float alA, alB, psum; bf16x8 pa0, pa1, pa2, pa3; VF vf; const int NT = seq / KVBLK;
  int s_prev = 2, s_cur = 0, s_next = 1;
#define ROT() do { const int t_ = s_prev; s_prev = s_cur; s_cur = s_next; s_next = t_; } while (0)
#define STEP(N0, N1, O0, O1, alN, alO, t) do { \
    const bool full_ = (t) + 2 < NT; \
    qkt(N0, N1, kp0 + s_cur * KSLOT, qr, negm); \
    finishP(O0, O1, alO, l_reg, pa0, pa1, pa2, pa3, psum); \
    _Pragma("unroll") for (int g_ = 0; g_ < 12; ++g_) { __builtin_amdgcn_sched_group_barrier(0x008, 1, 0); __builtin_amdgcn_sched_group_barrier(0x002, 5, 0); } \
    v_read(vf, vb0 + s_prev * VSLOT);     \
    if (full_) DMA_K((t) + 2, s_prev); if ((t) + 1 < NT) DMA_V((t) + 1, s_next);     \
    guard(psum, mhat, negm, alN); v_wait(vf); \
    pv_mma(o, vf, pa0, pa1, pa2, pa3); exps32(N0, N1); asm volatile("" : "+v"(N0), "+v"(N1)); \
    _Pragma("unroll") for (int g_ = 0; g_ < 8; ++g_) { __builtin_amdgcn_sched_group_barrier(0x008, 1, 0); __builtin_amdgcn_sched_group_barrier(0x002, 4, 0); } \
    RESC(alO); \
    if (full_) WAIT_STEP_BAR(); else WAIT_ALL_BAR(); \
    ROT(); } while (0)
  DMA_K(0, 0); DMA_V(0, 0); DMA_K(1, 1);
  WAIT_ALL_BAR();
  DMA_K(2, 2); DMA_V(1, 1);
  qkt(pA0, pA1, kp0, qr, negm);
  { const float dl = rowmax32(pA0, pA1); mhat = dl;
#pragma unroll
    for (int r = 0; r < 16; ++r) { pA0[r] -= dl; pA1[r] -= dl; }
#pragma unroll
    for (int r = 0; r < 16; ++r) negm[r] = -mhat;
    asm volatile("" : "+v"(negm)); alA = 1.f; }
  exps32(pA0, pA1); asm volatile("" : "+v"(pA0), "+v"(pA1));
  WAIT_ALL_BAR(); ROT();
  int t = 1;
  for (; t + 1 < NT; t += 2) {
    STEP(pB0, pB1, pA0, pA1, alB, alA, t);
    STEP(pA0, pA1, pB0, pB1, alA, alB, t + 1);
  }
  STEP(pB0, pB1, pA0, pA1, alB, alA, t);
  v_read(vf, vb0 + s_prev * VSLOT);
  finishP(pB0, pB1, 1.f, l_reg, pa0, pa1, pa2, pa3, psum); v_wait(vf);
  pv_mma(o, vf, pa0, pa1, pa2, pa3);
  { auto rr = __builtin_amdgcn_permlane32_swap(__float_as_uint(l_reg), __float_as_uint(l_reg), false, false); l_reg = __uint_as_float(rr[0]) + __uint_as_float(rr[1]); }
  if (hi == 0) li_l[r32] = l_reg; asm volatile("s_waitcnt lgkmcnt(0)" ::: "memory");
  float rli[16];
#pragma unroll
  for (int r = 0; r < 16; ++r) rli[r] = __builtin_amdgcn_rcpf(li_l[crow(r, hi)]);
  bf16* Ow = Ob + (long)(wid * QBLK) * LDO;
#pragma unroll
  for (int r = 0; r < 16; ++r) { int orow = crow(r, hi);
#pragma unroll
    for (int d0 = 0; d0 < 2; ++d0) Ow[(long)orow * LDO + d0 * 32 + r32] = __float2bfloat16(o[d0][r] * rli[r]); }
  asm volatile("s_waitcnt vmcnt(0) lgkmcnt(0)\n\ts_barrier" ::: "memory");
#undef DMA_K
#undef DMA_V
#undef WAIT_ALL_BAR
#undef WAIT_STEP_BAR
#undef RESC
#undef ROT
#undef STEP
}
#undef SBAR
}


#define XB_TMO      128
#define XB_XCNT(j)  (256  + 64 * (j))
#define XB_XSUB(j)  (1280 + 64 * (j))
#define XB_XGEN(j)  (2304 + 64 * (j))
#define XB_TOP      3328
#define XB_TOPGEN   3392
#define XCD_BAR_WORDS 3456
#define XB_SPIN_CAP (1u << 22)
__device__ __forceinline__ unsigned xb_ld(unsigned* p)              { return __hip_atomic_load(p, __ATOMIC_RELAXED, __HIP_MEMORY_SCOPE_AGENT); }
__device__ __forceinline__ unsigned xb_add(unsigned* p, unsigned v) { return __hip_atomic_fetch_add(p, v, __ATOMIC_RELAXED, __HIP_MEMORY_SCOPE_AGENT); }
__device__ __forceinline__ unsigned xb_xcc_id() { return (unsigned)__builtin_amdgcn_s_getreg((3 << 11) | 20) & 0xFu; }
#define XB_SPIN(cond, bar) do { unsigned _sp = 0; while (cond) { __builtin_amdgcn_s_sleep(1); \
    if ((++_sp & 255u) == 0u) { if (xb_ld(&(bar)[XB_TMO])) break; if (_sp > XB_SPIN_CAP) { atomicAdd(&(bar)[XB_TMO], 1u); break; } } } } while (0)
struct XcdBarrier { unsigned* bar; unsigned x; volatile LAS unsigned* st; };
__device__ __forceinline__ XcdBarrier xcd_barrier_post(unsigned* bar, volatile LAS unsigned* st) {
    XcdBarrier b; b.bar = bar; b.x = xb_xcc_id(); b.st = st;
    if (threadIdx.x == 0) (void)xb_add(&bar[XB_XCNT(b.x)], 1u);
    return b;
}
__device__ __forceinline__ void xcd_barrier_complete(unsigned* bar, unsigned x, unsigned& nloc, unsigned& nx) {
    const unsigned G = gridDim.x * gridDim.y * gridDim.z;
    unsigned sum, cnt, mine, sp = 0u;
    for (;;) {
        sum = 0u; cnt = 0u; mine = 0u;
#pragma unroll
        for (unsigned j = 0; j < 16; ++j) { const unsigned c = xb_ld(&bar[XB_XCNT(j)]); sum += c; cnt += (c > 0u) ? 1u : 0u; mine = (j == x) ? c : mine; }
        if (sum == G) break;
        __builtin_amdgcn_s_sleep(1);
        if ((++sp & 255u) == 0u) { if (xb_ld(&bar[XB_TMO])) break; if (sp > XB_SPIN_CAP) { atomicAdd(&bar[XB_TMO], 1u); break; } }
    }
    nloc = mine > 0u ? mine : 1u; nx = cnt > 0u ? cnt : 1u;
}
__device__ __forceinline__ void xcd_barrier(const XcdBarrier& b) {
    asm volatile("s_waitcnt vmcnt(0)" ::: "memory");
    __syncthreads();
    if (threadIdx.x == 0) {
        unsigned* bar = b.bar;
        __builtin_amdgcn_s_waitcnt(0);
        unsigned nloc = b.st[0], nx = b.st[1];
        if (nloc == 0u) { xcd_barrier_complete(bar, b.x, nloc, nx); b.st[0] = nloc; b.st[1] = nx; }
        const unsigned old = xb_add(&bar[XB_XSUB(b.x)], 1u);
        const unsigned gen = old / nloc;
        if (old + 1u == (gen + 1u) * nloc) {
            __builtin_amdgcn_fence(__ATOMIC_RELEASE, "agent");
            asm volatile("s_waitcnt vmcnt(0)" ::: "memory");
            const unsigned og = xb_add(&bar[XB_TOP], 1u);
            const unsigned tg = og / nx;
            if (og + 1u == (tg + 1u) * nx) xb_add(&bar[XB_TOPGEN], 1u);
            else XB_SPIN(xb_ld(&bar[XB_TOPGEN]) == tg, bar);
            __builtin_amdgcn_fence(__ATOMIC_ACQUIRE, "agent");
            xb_add(&bar[XB_XGEN(b.x)], 1u);
            asm volatile("s_waitcnt vmcnt(0)" ::: "memory");
        } else {
            XB_SPIN(xb_ld(&bar[XB_XGEN(b.x)]) == gen, bar);
            __builtin_amdgcn_fence(__ATOMIC_ACQUIRE, "agent");
            asm volatile("s_waitcnt vmcnt(0)" ::: "memory");
        }
    }
    __syncthreads();
}

template <class RowMap>
__device__ __forceinline__ void transpose_item(const float* W, int K, int N, bf16_t* WT, LAS float* scr, int item, int lane, const float* kscale, RowMap rm) {
    const int nblk = N / 32, kb = item / nblk, nb = item % nblk, k0 = 64 * kb, n0 = 32 * nb;
#pragma unroll 8
    for (int i = 0; i < 32; ++i) { const int kk = 2 * i + (lane >> 5); float v = W[(size_t)(k0 + kk) * N + n0 + (lane & 31)]; if (kscale) v *= kscale[k0 + kk]; scr[kk * 33 + (lane & 31)] = v; }
    asm volatile("s_waitcnt lgkmcnt(0)" ::: "memory");
    const int c = lane & 7;
#pragma unroll
    for (int j = 0; j < 4; ++j) { const int n = (lane >> 3) + 8 * j; const LAS float* s = scr + (8 * c) * 33 + n;
        u32x4 o; o.x = cvt_pk_bf16(s[0 * 33], s[1 * 33]); o.y = cvt_pk_bf16(s[2 * 33], s[3 * 33]); o.z = cvt_pk_bf16(s[4 * 33], s[5 * 33]); o.w = cvt_pk_bf16(s[6 * 33], s[7 * 33]);
        *(u32x4*)(WT + (size_t)rm(n0 + n) * K + k0 + 8 * c) = o; }
    asm volatile("s_waitcnt lgkmcnt(0)" ::: "memory");
}
template <int NR>
__device__ __forceinline__ void gemv_item(const float* W, int N, const LAS float* sv, float* dst, const float* bias, int cgp, int ks, int lane) {
    const int col = cgp * 256 + lane * 4; f32x4 acc[NR];
#pragma unroll
    for (int b = 0; b < NR; ++b) acc[b] = (f32x4){0.f, 0.f, 0.f, 0.f};
    const float* wp = W + (size_t)(ks * 128) * N + col;
#pragma unroll 4
    for (int k = 0; k < 128; ++k) { const f32x4 w = *(const f32x4*)(wp + (size_t)k * N);
#pragma unroll
        for (int b = 0; b < NR; ++b) acc[b] += w * sv[b * 1024 + ks * 128 + k]; }
#pragma unroll
    for (int b = 0; b < NR; ++b) { if (bias && ks == 0) acc[b] += *(const f32x4*)(bias + col);
#pragma unroll
        for (int i = 0; i < 4; ++i) unsafeAtomicAdd(dst + (size_t)b * N + col + i, acc[b][i]); }
}

__global__ void __launch_bounds__(512, 2) fwd(Args a) {
    extern __shared__ __attribute__((aligned(16))) unsigned char lds_raw[];
    LAS unsigned char* lds = (LAS unsigned char*)lds_raw;
    const int tid = threadIdx.x, lane = tid & 63, wave = __builtin_amdgcn_readfirstlane(tid >> 6);
    const int G = gridDim.x, bx = blockIdx.x, gw = bx * 8 + wave, NGW = G * 8;
    unsigned char* ws = a.ws;
    float* mod = (float*)(ws + WS_MOD); float* bias2 = (float*)(ws + WS_BIAS2);
    float* ssq_q = (float*)(ws + WS_SSQQ); float* ssq_kv = (float*)(ws + WS_SSQKV); float* ssq2 = (float*)(ws + WS_SSQ2); float* ssq3 = (float*)(ws + WS_SSQ3);
    float* tab = (float*)(ws + WS_TAB);
    bf16_t* WinT = (bf16_t*)(ws + WS_WIN); bf16_t* WuqT = (bf16_t*)(ws + WS_WUQ); bf16_t* WukvT = (bf16_t*)(ws + WS_WUKV); bf16_t* WbmT = (bf16_t*)(ws + WS_WBM);
    bf16_t* WppT = (bf16_t*)(ws + WS_WPP); bf16_t* WoutT = (bf16_t*)(ws + WS_WOUT); bf16_t* W1T = (bf16_t*)(ws + WS_W1); bf16_t* W2T = (bf16_t*)(ws + WS_W2);
    bf16_t* Hb = (bf16_t*)(ws + WS_H); bf16_t* Qb = (bf16_t*)(ws + WS_Q); bf16_t* Kb = (bf16_t*)(ws + WS_K); bf16_t* Vb = (bf16_t*)(ws + WS_V); bf16_t* Mg = (bf16_t*)(ws + WS_MERGED);
    bf16_t* Dp = (bf16_t*)(ws + WS_DPOOL); bf16_t* At = (bf16_t*)(ws + WS_ATTN); bf16_t* X1s = (bf16_t*)(ws + WS_X1S);
    bf16_t* X1b = (bf16_t*)(ws + WS_R1 + 132 * MiB);
    unsigned char* G8b = ws + WS_G8;
    bf16_t* Yb = (bf16_t*)(ws + WS_Y); bf16_t* Ub = (bf16_t*)(ws + WS_U);
    const int lo = a.ph_lo, hi_ph = a.ph_hi;
#if MK_COOP
    volatile LAS unsigned* bst = (volatile LAS unsigned*)(lds + LDS_BYTES - 64);
    if (tid < 16) bst[tid] = 0u;
    __syncthreads();
    XcdBarrier bar = xcd_barrier_post((unsigned*)(ws + WS_BAR), bst);
    if (lo < 0) cg::this_grid().sync();
#endif
#ifndef PHMASK
#define PHMASK 0x1ff
#endif
#define IN(k) (((PHMASK >> (k)) & 1) && lo <= (k) && (k) < hi_ph)
#if MK_COOP
#define SEAM(k) do { if (IN(k) && IN((k) + 1)) xcd_barrier(bar); } while (0)
#else
#define SEAM(k) do { } while (0)
#endif

    if (IN(0)) {
        LAS float* sil = (LAS float*)(lds + 73728);
        for (int i = tid; i < 9 * 1024; i += 512) { const int b = i >> 10, k = i & 1023; const float v = (b < 8) ? a.in[1][b * 1024 + k] : a.in[3][k]; sil[i] = v / (1.f + __expf(-v)); }
        __syncthreads();
        LAS float* scr = (LAS float*)(lds + wave * 8448);
        constexpr int I_ADA = 24 * 8, I_PP = 1024, I_IN = 16 * 101, I_UQ = 6 * 24, I_UKV = 4 * 32, I_BM = 8 * 32, I_OUT = 16 * 32, I_W1 = 16 * 128, I_W2 = 64 * 32, I_PAD = 96, I_TAB = 1;
        constexpr int NITEMS = I_ADA + I_PP + I_IN + I_UQ + I_UKV + I_BM + I_OUT + I_W1 + I_W2 + I_PAD + I_TAB;
        auto ident = [](int n) { return n; };
        for (int it = gw; it < NITEMS; it += NGW) {
            int r = it;
            if (r < I_ADA) { gemv_item<9>(a.in[4], 6144, sil, mod, a.in[5], r >> 3, r & 7, lane); continue; } r -= I_ADA;
            if (r < I_PP) {
                const int kc = r >> 4, nb = r & 15, k0 = kc * 8, gI = k0 >> 7, c0 = k0 & 127, n = nb * 64 + lane;
                const float* pw = a.in[13] + (size_t)(gI * 128 + c0) * 128; const float* psc = a.in[14] + gI * 128; const float* wb = a.in[15] + (size_t)(gI * 128) * 1024 + n;
                float ac[8] = {0.f, 0.f, 0.f, 0.f, 0.f, 0.f, 0.f, 0.f};
#pragma unroll 4
                for (int d = 0; d < 128; ++d) { const float wv = wb[(size_t)d * 1024] * psc[d];
#pragma unroll
                    for (int i = 0; i < 8; ++i) ac[i] += pw[i * 128 + d] * wv; }
                u32x4 o; o.x = cvt_pk_bf16(ac[0], ac[1]); o.y = cvt_pk_bf16(ac[2], ac[3]); o.z = cvt_pk_bf16(ac[4], ac[5]); o.w = cvt_pk_bf16(ac[6], ac[7]);
                *(u32x4*)(WppT + (size_t)n * 512 + k0) = o; continue; } r -= I_PP;
            if (r < I_IN) { transpose_item(a.in[7], 1024, 3232, WinT, scr, r, lane, nullptr, [](int n) { return n < 384 ? n : (n < 640 ? n + 128 : (n < 672 ? n - 256 : n + 96)); }); continue; } r -= I_IN;
            if (r < I_UQ) { transpose_item(a.in[10], 384, 768, WuqT, scr, r, lane, a.in[8], [](int n) { const int d = n % 96; if (d < 64) return n; const int p = d - 64, part = p >> 4, half = (p >> 3) & 1, j = p & 7;
                                return n - d + 64 + 8 * (part * 2 + (j >> 2)) + 4 * half + (j & 3); }); continue; } r -= I_UQ;
            if (r < I_UKV) { transpose_item(a.in[11], 256, 1024, WukvT, scr, r, lane, a.in[9], [](int n) { const int h = n >> 7, e = n & 127; return e < 64 ? h * 64 + e : 512 + h * 64 + (e - 64); }); continue; } r -= I_UKV;
            if (r < I_BM) { transpose_item(a.in[12], 512, 1024, WbmT, scr, r, lane, nullptr, ident); continue; } r -= I_BM;
            if (r < I_OUT) { transpose_item(a.in[16], 1024, 1024, WoutT, scr, r, lane, nullptr, ident); continue; } r -= I_OUT;
            if (r < I_W1) { transpose_item(a.in[18], 1024, 4096, W1T, scr, r, lane, nullptr, ident); continue; } r -= I_W1;
            if (r < I_W2) { transpose_item(a.in[19], 4096, 1024, W2T, scr, r, lane, nullptr, ident); continue; } r -= I_W2;
            if (r < I_PAD) { u32x4 z = {0u, 0u, 0u, 0u}; u32x4* p = (u32x4*)(WinT + (size_t)(416 + r) * 1024); p[lane] = z; p[64 + lane] = z; continue; } r -= I_PAD;
            {
                for (int e = lane; e < 1024; e += 64) { const int pos = e >> 3, j = e & 7; const float invf = powf(10000.0f, -(float)(2 * j) / 16.0f); const float ang = (float)pos * invf;
                    tab[2 * e] = cosf(ang); tab[2 * e + 1] = sinf(ang); } }
        }
    }
    SEAM(0);

    if (IN(1)) {
        LAS float* sh2 = (LAS float*)(lds + 73728);
        for (int i = tid; i < 8 * 1024; i += 512) sh2[i] = mod[(i >> 10) * 6144 + 3072 + (i & 1023)];
        __syncthreads();
        if (gw < 128) gemv_item<8>(a.in[18], 4096, sh2, bias2, nullptr, gw >> 3, gw & 7, lane);
        const float* g1 = a.in[6];
        for (int r = gw; r < MEXT; r += NGW) {
            const int b = r / EXT, j = r - b * EXT; const bool isctx = j < CTXL;
            const float* src = isctx ? a.in[2] + (size_t)(b * CTXL + j) * DM : a.in[0] + (size_t)(b * SEQ + j - CTXL) * DM; const float* mb = mod + (isctx ? 8 : b) * 6144;
            f32x4 v[4]; float s = 0.f;
#pragma unroll
            for (int q = 0; q < 4; ++q) { v[q] = *(const f32x4*)(src + 4 * lane + 256 * q); s += (v[q][0] * v[q][0] + v[q][1] * v[q][1]) + (v[q][2] * v[q][2] + v[q][3] * v[q][3]); }
            const float rstd = 1.0f / sqrtf(wave_sum(s) * (1.0f / DM) + EPS);
#pragma unroll
            for (int q = 0; q < 4; ++q) { const int col = 4 * lane + 256 * q; const f32x4 g = *(const f32x4*)(g1 + col), sc = *(const f32x4*)(mb + 1024 + col), sh = *(const f32x4*)(mb + col);
                const f32x4 o = v[q] * rstd * g * (sc + 1.0f) + sh; u32x2 w; w.x = cvt_pk_bf16(o[0], o[1]); w.y = cvt_pk_bf16(o[2], o[3]);
                *(u32x2*)(Hb + (size_t)r * DM + col) = w; }
        }
    }
    SEAM(1);

    if (IN(2)) {
        pg8::Gemm g{Hb, WinT, DM, DM}; pg8::Order S; S.init(MEXT / 256, NWIN / 256, G, bx, 0);
        pg8::EpiY E{Yb, G8b, ssq_q, ssq_kv};
        pg8::gemm_phase(lds, g, S, E);
    }
    SEAM(2);

    if (IN(3)) {
#ifndef NO_P3A
        { pg8::Gemm g{Yb + Y_CQ, WuqT, YW, 384}; pg8::Order S; S.init(MLAT / 256, QW / 256, G, bx, 1);
          pg8::EpiQ E{Qb, ssq_q}; pg8::gemm_phase(lds, g, S, E); }
#endif
#ifndef NO_P3B
        { pg8::Gemm g{Yb + Y_CKV, WukvT, YW, 256}; pg8::Order S; S.init(MEXT / 256, 1024 / 256, G, bx, 0);
          pg8::EpiKV E{Kb, ssq_kv}; pg8::gemm_phase(lds, g, S, E); }
#endif
        const int gt = bx * 512 + tid, NTH = G * 512;
#ifndef NO_P3C
        for (int idx = gt; idx < MEXT * 4; idx += NTH) {
            const int r = idx >> 2, fq = idx & 3, b = r / EXT, j = r - b * EXT, part = fq >> 1, j0 = 4 * (fq & 1);
            const bf16_t* src = Yb + (size_t)r * YW + Y_KR + part * 16 + j0;
            const u32x2 a1 = *(const u32x2*)src, a2 = *(const u32x2*)(src + 8);
            f32x4 x1 = (f32x4){bf_lo(a1.x), bf_hi(a1.x), bf_lo(a1.y), bf_hi(a1.y)}, x2 = (f32x4){bf_lo(a2.x), bf_hi(a2.x), bf_lo(a2.y), bf_hi(a2.y)};
            if (j >= CTXL) { const int t = j - CTXL, pos = part ? (t & 63) : (t >> 6); const float* tp = tab + pos * 16 + j0 * 2;
                const f32x4 t0 = *(const f32x4*)tp, t1 = *(const f32x4*)(tp + 4);
                const f32x4 cs = (f32x4){t0[0], t0[2], t1[0], t1[2]}, sn = (f32x4){t0[1], t0[3], t1[1], t1[3]};
                const f32x4 o1 = x1 * cs - x2 * sn, o2 = x1 * sn + x2 * cs; x1 = o1; x2 = o2; }
            const u32x4 w = pack8(x1, x2);
#pragma unroll
            for (int h = 0; h < NH; ++h) *(u32x4*)(Kb + ((size_t)((b * NH + h) * (EXT / 64) + (j >> 6)) * 12 + 8 + fq) * 512 + (size_t)(j & 63) * 8) = w;
        }
#endif
#ifndef NO_P3D
        for (int idx = gt; idx < (MLAT / 32) * 64; idx += NTH) {
            const int seg = idx >> 6, ch = idx & 63, b = seg >> 8, t0 = (seg & 255) << 5, half = 1 << (ch >> 4);
            const bf16_t* base = Yb + (size_t)(b * EXT + CTXL) * YW + Y_POOL + ch * 8;
            bf16_t* dst = Dp + (size_t)(b * EXT + CTXL) * 512 + ch * 8;
            f32x4 s0 = (f32x4){0.f, 0.f, 0.f, 0.f}, s1 = s0;
            for (int sidx = max(t0 - half, 0); sidx < min(t0 + half, SEQ); ++sidx) { f32x4 p0, p1; unpack8(*(const u32x4*)(base + (size_t)sidx * YW), p0, p1); s0 += p0; s1 += p1; }
#pragma unroll 4
            for (int t = t0; t < t0 + 32; ++t) {
                const int cnt = min(t + half, SEQ) - max(t - half, 0); const float inv = 1.0f / (float)cnt;
                f32x4 c0, c1; unpack8(*(const u32x4*)(base + (size_t)t * YW), c0, c1);
                *(u32x4*)(dst + (size_t)t * 512) = pack8(s0 * inv - c0, s1 * inv - c1);
                if (t + half < SEQ) { f32x4 p0, p1; unpack8(*(const u32x4*)(base + (size_t)(t + half) * YW), p0, p1); s0 += p0; s1 += p1; }
                if (t - half >= 0) { f32x4 p0, p1; unpack8(*(const u32x4*)(base + (size_t)(t - half) * YW), p0, p1); s0 -= p0; s1 -= p1; }
            }
        }
#endif
    }
    SEAM(3);

    if (IN(4)) {
        const int xcd = bx & 7, loc = bx >> 3, per = G >> 3;
        for (int rep = 0; rep < REP4; ++rep)
        for (int i = 0; i < 8; ++i) {
            const int bh = xcd * 8 + i, b = bh >> 3, h = bh & 7;
            for (int qb = loc; qb < 32; qb += per) {
                const size_t krow0 = (size_t)b * EXT, qrow0 = krow0 + CTXL + (size_t)qb * 256;
                att::attn_unit((const att::bf16*)(Qb + qrow0 * QW + h * QKD), (const att::bf16*)(Kb + (size_t)bh * EXT * QKD), (const att::bf16*)(Vb + (size_t)bh * EXT * 64),
                               (att::bf16*)(At + qrow0 * VW + h * 64), EXT, (char*)lds_raw, tab, qb * 256);
            }
        }
    }
    SEAM(4);

    if (IN(5)) {
        { pg8::Gemm g{At, WbmT, 512, 512}; pg8::Order S; S.init(MLAT / 256, 4, G, bx, 1); pg8::EpiMerge<0> E{Mg, G8b}; pg8::gemm_phase(lds, g, S, E); }
        { pg8::Gemm g{Dp, WppT, 512, 512}; pg8::Order S; S.init(MLAT / 256, 4, G, bx, 1); pg8::EpiMerge<1> E{Mg, G8b}; pg8::gemm_phase(lds, g, S, E); }
    }
    SEAM(5);

    if (IN(6)) {
        pg8::Gemm g{Mg, WoutT, DM, DM}; pg8::Order S; S.init(MLAT / 256, 4, G, bx, 1);
        pg8::EpiOut E{a.in[0], X1b, X1s, mod, a.in[17], ssq2}; pg8::gemm_phase(lds, g, S, E);
    }
    SEAM(6);

    if (IN(7)) {
        pg8::Gemm g{X1s, W1T, DM, DM, 1}; pg8::Order S; S.init(MLAT / 256, DFF / 256, G, bx, 1);
        pg8::EpiUp E{Ub, ssq2, bias2}; for (int rep = 0; rep < REP7; ++rep) pg8::gemm_phase(lds, g, S, E);
    }
    SEAM(7);

    if (IN(8)) {
        pg8::Gemm g{Ub, W2T, DFF, DFF, 1}; pg8::Order S; S.init(MLAT / 256, 4, G, bx, 1);
        pg8::EpiDown E{a.out, X1b, mod, a.in[20], (float*)(ws + WS_XBUF), (unsigned*)(ws + WS_XCNT), lds + 131072}; pg8::gemm_phase(lds, g, S, E);
    }
#undef IN
#undef SEAM
}

extern "C" void kernel_launch(void* const* d_in, const int* in_sizes, int n_in, void* d_out, int out_size, void* d_ws, size_t ws_size, hipStream_t stream) {
    static int grid = 0;
    if (grid == 0) {
        if (n_in != 21 || in_sizes[0] != MLAT * DM || out_size != MLAT * DM || ws_size < WS_END) {
            fprintf(stderr, "kernel_launch: shape mismatch n_in %d in0 %d out %d ws %zu (need %zu)\n", n_in, n_in > 0 ? in_sizes[0] : -1, out_size, ws_size, (size_t)WS_END); grid = -1; return; }
        int dev = 0, cus = 0, per_cu = 0;
        hipGetDevice(&dev); hipDeviceGetAttribute(&cus, hipDeviceAttributeMultiprocessorCount, dev);
        if (hipFuncSetAttribute((const void*)fwd, hipFuncAttributeMaxDynamicSharedMemorySize, LDS_BYTES) != hipSuccess) { fprintf(stderr, "kernel_launch: hipFuncSetAttribute failed\n"); grid = -1; return; }
        if (hipOccupancyMaxActiveBlocksPerMultiprocessor(&per_cu, (const void*)fwd, 512, LDS_BYTES) != hipSuccess || per_cu < 1) { fprintf(stderr, "kernel_launch: occupancy query says %d\n", per_cu); per_cu = 1; }
        (void)hipGetLastError();
        grid = cus;
        if (grid != 256) fprintf(stderr, "kernel_launch: note: %d CUs\n", grid);
    }
    if (grid < 0) return;
    hipMemsetAsync(d_ws, 0, ZERO_BYTES, stream);
    Args a{};
    for (int i = 0; i < 21; ++i) a.in[i] = (const float*)d_in[i];
    a.out = (float*)d_out; a.ws = (unsigned char*)d_ws;
#if MK_COOP
    a.ph_lo = 0; a.ph_hi = NPHASE;
    void* args[] = {&a};
    hipError_t e = hipLaunchCooperativeKernel((const void*)fwd, dim3(grid), dim3(512), args, LDS_BYTES, stream);
    if (e != hipSuccess) fprintf(stderr, "kernel_launch: cooperative launch failed: %s (grid %d)\n", hipGetErrorString(e), grid);
#else
    for (int p = 0; p < NPHASE; ++p) { a.ph_lo = p; a.ph_hi = p + 1; hipLaunchKernelGGL(fwd, dim3(grid), dim3(512), LDS_BYTES, stream, a); }
#endif
}
```

```cpp
#include <hip/hip_runtime.h>
#include <hip/hip_bf16.h>
#include <hip/hip_cooperative_groups.h>
#include <cstdio>
#include <cstdint>
namespace cg = cooperative_groups;

#ifndef REP4
#define REP4 1
#endif
#ifndef REP7
#define REP7 1
#endif
#ifndef REP2
#define REP2 1
#endif
#ifndef MK_COOP
#define MK_COOP 1
#endif

#define LAS __attribute__((address_space(3)))
typedef unsigned short bf16_t;
typedef short bf16x8 __attribute__((ext_vector_type(8)));
typedef short s16x4 __attribute__((ext_vector_type(4)));
typedef float f32x4 __attribute__((ext_vector_type(4)));
typedef float f32x2 __attribute__((ext_vector_type(2)));
typedef float f32x16 __attribute__((ext_vector_type(16)));
typedef unsigned u32x4 __attribute__((ext_vector_type(4)));
typedef unsigned u32x2 __attribute__((ext_vector_type(2)));

constexpr int DM = 1024, NB = 8, SEQ = 8192, CTXL = 256, EXT = SEQ + CTXL, MEXT = NB * EXT, MLAT = NB * SEQ;
constexpr int NH = 8, QKD = 96, QW = NH * QKD  , VW = 512, DFF = 4096;
constexpr int NWIN = 3328;
constexpr int YW = 1280;
constexpr int GW8 = 2048;
constexpr int Y_CQ = 0, Y_KR = 384, Y_CKV = 512, Y_POOL = 768, Y_GM = 1280, Y_GP = 2304;
constexpr float EPS = 1e-6f;
constexpr float QSCALE_LOG2E = 0.10206207261596575f * 1.4426950408889634f;
constexpr int NPHASE = 9;
constexpr int LDS_BYTES = 147456;

constexpr size_t KiB = 1024, MiB = 1024 * 1024;
constexpr size_t WS_R3_ = 296 * MiB;
constexpr size_t WS_MOD = 0, WS_BIAS2 = 256 * KiB, WS_SSQQ = 384 * KiB, WS_SSQKV = 656 * KiB, WS_SSQ2 = 928 * KiB, WS_SSQ3 = 1200 * KiB, ZERO_BYTES = 1536 * KiB;
constexpr size_t WS_BAR = 1472 * KiB;
constexpr size_t WS_XCNT = 1488 * KiB;
constexpr size_t WS_XBUF = WS_R3_;
constexpr size_t WS_TAB = 1536 * KiB;
constexpr size_t WS_WIN = 2 * MiB, WS_WUQ = 9 * MiB, WS_WUKV = 10 * MiB, WS_WBM = 11 * MiB, WS_WPP = 12 * MiB, WS_WOUT = 13 * MiB, WS_W1 = 15 * MiB, WS_W2 = 23 * MiB;
constexpr size_t WS_R1 = 32 * MiB;
constexpr size_t WS_H = WS_R1, WS_Q = WS_R1, WS_K = WS_R1 + 99 * MiB, WS_V = WS_R1 + 198 * MiB, WS_MERGED = WS_R1;
constexpr size_t WS_R3 = 296 * MiB;
constexpr size_t WS_DPOOL = WS_R3, WS_ATTN = WS_R3 + 66 * MiB, WS_X1S = WS_R3;
constexpr size_t WS_R2 = 428 * MiB;
constexpr size_t WS_Y = WS_R2, WS_G8 = WS_R2 + 166 * MiB, WS_U = WS_R2;
constexpr size_t WS_END = 956 * MiB;
static_assert((size_t)MEXT * 1024 * 2 == 132 * MiB && (size_t)MEXT * 768 * 2 == 99 * MiB && (size_t)MEXT * 512 * 2 == 66 * MiB, "sizes");
static_assert((size_t)MEXT * DFF * 2 == 528 * MiB && (size_t)MEXT * YW * 2 <= 166 * MiB && (size_t)MEXT * GW8 == 132 * MiB, "sizes");

struct Args { const float* in[21]; float* out; unsigned char* ws; int ph_lo, ph_hi; };

__device__ __forceinline__ unsigned cvt_pk_bf16(float lo, float hi) { unsigned r; asm volatile("v_cvt_pk_bf16_f32 %0, %1, %2" : "=v"(r) : "v"(lo), "v"(hi)); return r; }
__device__ __forceinline__ float bf_lo(unsigned w) { return __uint_as_float(w << 16); }
__device__ __forceinline__ float bf_hi(unsigned w) { return __uint_as_float(w & 0xffff0000u); }
__device__ __forceinline__ float wave_sum(float v) {
#pragma unroll
    for (int o = 1; o < 64; o <<= 1) v += __shfl_xor(v, o);
    return v;
}
__device__ __forceinline__ float sigmoidf_(float x) { return __builtin_amdgcn_rcpf(1.f + __expf(-x)); }
__device__ __forceinline__ u32x4 pack8(f32x4 a, f32x4 b) { u32x4 w; w.x = cvt_pk_bf16(a[0], a[1]); w.y = cvt_pk_bf16(a[2], a[3]); w.z = cvt_pk_bf16(b[0], b[1]); w.w = cvt_pk_bf16(b[2], b[3]); return w; }
__device__ __forceinline__ void unpack8(u32x4 w, f32x4& a, f32x4& b) { a = (f32x4){bf_lo(w.x), bf_hi(w.x), bf_lo(w.y), bf_hi(w.y)}; b = (f32x4){bf_lo(w.z), bf_hi(w.z), bf_lo(w.w), bf_hi(w.w)}; }

namespace pg8 {
constexpr int BM = 256, BK = 64, HALF = 128, HTB = HALF * BK * 2, STAGE_BYTES = 8 * HTB, NXCD = 8, WGM = 8;
__host__ __device__ __forceinline__ int lds_byte(int r, int c) { const int st = (r >> 4) * 2 + (c >> 5), rr = r & 15, cc = c & 31, ob = rr * 64 + cc * 2; return st * 1024 + (ob ^ (((ob >> 9) & 1) << 5)); }
__host__ __device__ __forceinline__ void stage_rc(int b, int& R, int& C) { const int st = b / 1024, sb = b % 1024, swz = sb ^ (((sb >> 9) & 1) << 5); R = (st >> 1) * 16 + swz / 64; C = (st & 1) * 32 + (swz % 64) / 2; }
__host__ __device__ __forceinline__ int perm32(int rho) { const int n = rho >> 4, i = rho & 15; return 8 * (i >> 2) + 4 * n + (i & 3); }

struct Unit { int pm, pn, rnd; };
struct Gemm { const bf16_t* A; const bf16_t* Bt; int lda, K, tiledA = 0; };

struct Order {
    int nM, nN, nwg, G, c, latent;
    __device__ void init(int nM_, int nN_, int G_, int c_, int latent_) { nM = nM_; nN = nN_; nwg = nM * nN; G = G_; c = c_; latent = latent_; }
    __device__ bool next(int i, Unit& u) const {
        const long L = (long)i * G + c; if (L >= nwg) return false;
        int wgid = (int)L; { const int q = nwg / NXCD, r = nwg % NXCD, xcd = wgid % NXCD, off = wgid / NXCD; wgid = (xcd < r ? xcd * (q + 1) : r * (q + 1) + (xcd - r) * q) + off; }
        const int nig = WGM * nN, gid = wgid / nig, fm = gid * WGM, gsz = (nM - fm) < WGM ? (nM - fm) : WGM;
        int pm = fm + ((wgid % nig) % gsz); u.pn = (wgid % nig) / gsz;
        u.pm = latent ? pm + (pm >> 5) + 1 : pm; u.rnd = i; return true;
    }
};

template <class Epi, class Sched>
__device__ __forceinline__ void gemm_phase(LAS unsigned char* lds, const Gemm g, const Sched& S, const Epi& E) {
    int tid_ = threadIdx.x; asm volatile("" : "+v"(tid_));
    const int tid = tid_, wid = __builtin_amdgcn_readfirstlane(tid >> 6), lane = tid & 63, wr = wid >> 2, wc = wid & 3, fr = lane & 15, fq = lane >> 4;
    const int K = g.K, nt = K / BK, lda = g.lda;
    unsigned voffA[2], voffB[2];
#pragma unroll
    for (int i = 0; i < 2; ++i) { int R, C; stage_rc(tid * 16 + i * 8192, R, C); const int Rb = (R & ~31) + perm32(R & 31);
        voffA[i] = g.tiledA ? (unsigned)(tid * 16 + i * 8192) : (unsigned)(R * lda + C) * 2u; voffB[i] = (unsigned)(Rb * K + C) * 2u; }
    const size_t kstep = (size_t)(BK * 2), kstepA = g.tiledA ? (size_t)HTB : kstep;
    const size_t hstepA = g.tiledA ? (size_t)(K / BK) * HTB : (size_t)HALF * lda * 2, hstepB = (size_t)HALF * K * 2;
    const size_t tstepA = 2 * hstepA, tstepB = 2 * hstepB;
    const unsigned ldsw = (unsigned)wid * 1024u;
    const int aoff = lds_byte(wr * 64 + fr, fq * 8), boff = lds_byte(wc * 32 + fr, fq * 8);
#define PG8_SA(b, h) (((b) * 2 + (h)) * HTB)
#define PG8_SB(b, h) ((4 + (b) * 2 + (h)) * HTB)
#define PG8_STAGE(bufoff, gbase, voff) do { _Pragma("unroll") for (int _i = 0; _i < 2; ++_i) \
        __builtin_amdgcn_global_load_lds((const unsigned*)((const char*)(gbase) + (voff)[_i]), (LAS unsigned*)(lds + (bufoff) + ldsw + _i * 8192), 16, 0, 0); } while (0)
#define PG8_LDA(dst, b, h) do { _Pragma("unroll") for (int m = 0; m < 4; ++m) _Pragma("unroll") for (int k = 0; k < 2; ++k) dst[m][k] = *(const LAS bf16x8*)(lds + PG8_SA(b, h) + aoff + m * 2048 + k * 1024); } while (0)
#define PG8_LDB(dst, b, h) do { _Pragma("unroll") for (int n = 0; n < 2; ++n) _Pragma("unroll") for (int k = 0; k < 2; ++k) dst[n][k] = *(const LAS bf16x8*)(lds + PG8_SB(b, h) + boff + n * 2048 + k * 1024); } while (0)
#define PG8_MMA(ai, bj, At, Bt) do { __builtin_amdgcn_s_setprio(1); _Pragma("unroll") for (int m = 0; m < 4; ++m) _Pragma("unroll") for (int n = 0; n < 2; ++n) _Pragma("unroll") for (int k = 0; k < 2; ++k) \
        acc[ai][bj][m][n] = __builtin_amdgcn_mfma_f32_16x16x32_bf16(Bt[n][k], At[m][k], acc[ai][bj][m][n], 0, 0, 0); __builtin_amdgcn_s_setprio(0); } while (0)
#define PG8_WAIT_V(n) asm volatile("s_waitcnt vmcnt(" #n ")" ::: "memory")
#define PG8_WAIT_L(n) asm volatile("s_waitcnt lgkmcnt(" #n ")" ::: "memory")
#define PG8_BAR __builtin_amdgcn_s_barrier()
#define PG8_SCHED __builtin_amdgcn_sched_barrier(0)
    Unit cur, nxt; int ui = 0;
    if (!S.next(0, cur)) return;
    f32x4 acc[2][2][4][2];
#pragma unroll
    for (int a = 0; a < 2; ++a)
#pragma unroll
        for (int b = 0; b < 2; ++b)
#pragma unroll
            for (int m = 0; m < 4; ++m)
#pragma unroll
                for (int n = 0; n < 2; ++n) acc[a][b][m][n] = (f32x4){0.f, 0.f, 0.f, 0.f};
    bf16x8 At[4][2], B0[2][2], B1[2][2];
    const char* cA = (const char*)g.A + (size_t)cur.pm * tstepA; const char* cB = (const char*)g.Bt + (size_t)cur.pn * tstepB;
    PG8_STAGE(PG8_SB(0, 0), cB, voffB); PG8_STAGE(PG8_SB(0, 1), cB + hstepB, voffB); PG8_STAGE(PG8_SA(0, 0), cA, voffA); PG8_STAGE(PG8_SA(0, 1), cA + hstepA, voffA);
    if (wr == 1) PG8_BAR;
    PG8_WAIT_V(2); PG8_BAR;
    PG8_STAGE(PG8_SB(1, 0), cB + kstep, voffB); PG8_STAGE(PG8_SA(1, 0), cA + kstepA, voffA); PG8_STAGE(PG8_SB(1, 1), cB + hstepB + kstep, voffB);
    PG8_WAIT_V(6); PG8_BAR;
    for (;;) {
        const bool has_next = S.next(ui + 1, nxt);
        const char* nA = has_next ? (const char*)g.A + (size_t)nxt.pm * tstepA : cA; const char* nB = has_next ? (const char*)g.Bt + (size_t)nxt.pn * tstepB : cB;
#pragma unroll 1
        for (int t = 0; t < nt; t += 2) {
            const bool last = (t == nt - 2);
            const char* a1 = cA + (size_t)(t + 1) * kstepA;
            const char* a2 = last ? nA : cA + (size_t)(t + 2) * kstepA; const char* b2 = last ? nB : cB + (size_t)(t + 2) * kstep;
            const char* a3 = a2 + kstepA; const char* b3 = b2 + kstep;
            PG8_LDB(B0, 0, 0); PG8_LDB(B1, 0, 1); PG8_SCHED; PG8_LDA(At, 0, 0); PG8_STAGE(PG8_SA(1, 1), a1 + hstepA, voffA);
            PG8_WAIT_V(8); PG8_WAIT_L(0); PG8_BAR; PG8_MMA(0, 0, At, B0); PG8_MMA(0, 1, At, B1); PG8_BAR; PG8_SCHED;
            PG8_LDA(At, 0, 1); PG8_STAGE(PG8_SB(0, 0), b2, voffB); PG8_STAGE(PG8_SB(0, 1), b2 + hstepB, voffB); PG8_STAGE(PG8_SA(0, 0), a2, voffA);
            PG8_WAIT_V(8); PG8_WAIT_L(0); PG8_BAR; PG8_MMA(1, 0, At, B0); PG8_MMA(1, 1, At, B1); PG8_BAR; PG8_SCHED;
            PG8_LDB(B0, 1, 0); PG8_LDB(B1, 1, 1); PG8_SCHED; PG8_LDA(At, 1, 0); PG8_STAGE(PG8_SA(0, 1), a2 + hstepA, voffA);
            PG8_WAIT_V(8); PG8_WAIT_L(0); PG8_BAR; PG8_MMA(0, 0, At, B0); PG8_MMA(0, 1, At, B1); PG8_BAR; PG8_SCHED;
            PG8_LDA(At, 1, 1); PG8_STAGE(PG8_SB(1, 0), b3, voffB); PG8_STAGE(PG8_SB(1, 1), b3 + hstepB, voffB); PG8_STAGE(PG8_SA(1, 0), a3, voffA);
            PG8_WAIT_V(8); PG8_WAIT_L(0); PG8_BAR; PG8_MMA(1, 0, At, B0); PG8_MMA(1, 1, At, B1); PG8_BAR; PG8_SCHED;
        }
        if (wr == 0) PG8_BAR;
        E(acc, cur, wr, wc, fr, fq);
        if (!has_next) break;
#pragma unroll
        for (int a = 0; a < 2; ++a)
#pragma unroll
            for (int b = 0; b < 2; ++b)
#pragma unroll
                for (int m = 0; m < 4; ++m)
#pragma unroll
                    for (int n = 0; n < 2; ++n) acc[a][b][m][n] = (f32x4){0.f, 0.f, 0.f, 0.f};
        cur = nxt; cA = nA; cB = nB; ++ui;
        if (wr == 1) PG8_BAR;
    }
    PG8_WAIT_V(0);
    PG8_BAR;
#undef PG8_SA
#undef PG8_SB
#undef PG8_STAGE
#undef PG8_LDA
#undef PG8_LDB
#undef PG8_MMA
#undef PG8_WAIT_V
#undef PG8_WAIT_L
#undef PG8_BAR
#undef PG8_SCHED
}

typedef f32x4 (&AccRef)[2][2][4][2];
#define EPI_ROWS(u) const int row0_ = (u).pm * BM + wr * 64 + fr; const int colb_ = (u).pn * BM + wc * 32 + 8 * fq;
#define EPI_ROW(ai, m) (row0_ + (ai) * HALF + (m) * 16)
#define EPI_COL(bj) (colb_ + (bj) * HALF)

struct EpiY { bf16_t* Y; unsigned char* G8; float* ssq_q; float* ssq_kv;
    __device__ __forceinline__ void operator()(AccRef acc, const Unit& u, int wr, int wc, int fr, int fq) const {
        EPI_ROWS(u)
        if (u.pn >= 5) {
#pragma unroll
            for (int ai = 0; ai < 2; ++ai)
#pragma unroll
                for (int m = 0; m < 4; ++m) { const int row = EPI_ROW(ai, m);
#pragma unroll
                    for (int bj = 0; bj < 2; ++bj) { const f32x4 v0 = acc[ai][bj][m][0], v1 = acc[ai][bj][m][1]; unsigned q[8];
#pragma unroll
                        for (int i = 0; i < 4; ++i) { q[i] = (unsigned)(sigmoidf_(v0[i]) * 255.f + 0.5f); q[4 + i] = (unsigned)(sigmoidf_(v1[i]) * 255.f + 0.5f); }
                        u32x2 w; w.x = q[0] | (q[1] << 8) | (q[2] << 16) | (q[3] << 24); w.y = q[4] | (q[5] << 8) | (q[6] << 16) | (q[7] << 24);
                        *(u32x2*)(G8 + (size_t)row * GW8 + (EPI_COL(bj) - 1280)) = w; } }
            return; }
        const int mode = (u.pn == 0) ? 1 : (u.pn == 1 ? 2 : (u.pn == 2 ? 3 : 0));
#pragma unroll
        for (int ai = 0; ai < 2; ++ai)
#pragma unroll
            for (int m = 0; m < 4; ++m) { const int row = EPI_ROW(ai, m); float s = 0.f;
#pragma unroll
                for (int bj = 0; bj < 2; ++bj) { const f32x4 v0 = acc[ai][bj][m][0], v1 = acc[ai][bj][m][1];
                    *(u32x4*)(Y + (size_t)row * YW + EPI_COL(bj)) = pack8(v0, v1);
                    if (mode == 1 || mode == 3 || (mode == 2 && bj == 0)) s += (v0[0] * v0[0] + v0[1] * v0[1]) + (v0[2] * v0[2] + v0[3] * v0[3]) + (v1[0] * v1[0] + v1[1] * v1[1]) + (v1[2] * v1[2] + v1[3] * v1[3]); }
                if (mode) { s += __shfl_xor(s, 16); s += __shfl_xor(s, 32); if (fq == 0) unsafeAtomicAdd((mode == 3 ? ssq_kv : ssq_q) + row, s); } }
    }
};
struct EpiQ { bf16_t* Q; const float* ssq_q;
    __device__ __forceinline__ void operator()(AccRef acc, const Unit& u, int wr, int wc, int fr, int fq) const {
        EPI_ROWS(u)
#pragma unroll
        for (int ai = 0; ai < 2; ++ai)
#pragma unroll
            for (int m = 0; m < 4; ++m) { const int row = EPI_ROW(ai, m); const float rstd = QSCALE_LOG2E / sqrtf(ssq_q[row] * (1.0f / 384.0f) + EPS);
#pragma unroll
                for (int bj = 0; bj < 2; ++bj) *(u32x4*)(Q + (size_t)row * QW + EPI_COL(bj)) = pack8(acc[ai][bj][m][0] * rstd, acc[ai][bj][m][1] * rstd); }
    }
};
struct EpiKV { bf16_t* Kb; const float* ssq_kv;
    __device__ __forceinline__ void operator()(AccRef acc, const Unit& u, int wr, int wc, int fr, int fq) const {
        EPI_ROWS(u)
        const int bt = u.pm / 33;
#pragma unroll
        for (int ai = 0; ai < 2; ++ai)
#pragma unroll
            for (int m = 0; m < 4; ++m) { const int row = EPI_ROW(ai, m); const float rstd = 1.0f / sqrtf(ssq_kv[row] * (1.0f / 256.0f) + EPS);
#pragma unroll
                for (int bj = 0; bj < 2; ++bj) { const f32x4 v0 = acc[ai][bj][m][0] * rstd, v1 = acc[ai][bj][m][1] * rstd; const int col = EPI_COL(bj);
                    const int hh = (col >> 6) & 7, dd = col & 63; const size_t hk = (size_t)((bt * NH + hh) * EXT + (row - bt * EXT));
                    const int key_ = row - bt * EXT;
                    const size_t koff_ = ((size_t)((bt * NH + hh) * (EXT / 64) + (key_ >> 6)) * 12 + (dd >> 3)) * 512 + (size_t)(key_ & 63) * 8;
                    const size_t off = (col < 512) ? koff_ : (size_t)((WS_V - WS_K) / 2) + hk * 64 + dd;
                    *(u32x4*)(Kb + off) = pack8(v0, v1); } }
    }
};
template <int SECOND> struct EpiMerge { bf16_t* Mg; const unsigned char* G8;
    __device__ __forceinline__ void operator()(AccRef acc, const Unit& u, int wr, int wc, int fr, int fq) const {
        EPI_ROWS(u)
#pragma unroll
        for (int ai = 0; ai < 2; ++ai)
#pragma unroll
            for (int m = 0; m < 4; ++m) { const int row = EPI_ROW(ai, m);
#pragma unroll
                for (int bj = 0; bj < 2; ++bj) { const int col = EPI_COL(bj); const u32x2 gq = *(const u32x2*)(G8 + (size_t)row * GW8 + (SECOND ? 1024 : 0) + col);
                    f32x4 v0 = acc[ai][bj][m][0], v1 = acc[ai][bj][m][1];
#pragma unroll
                    for (int i = 0; i < 4; ++i) { v0[i] *= (float)((gq.x >> (8 * i)) & 255u) * (1.0f / 255.0f); v1[i] *= (float)((gq.y >> (8 * i)) & 255u) * (1.0f / 255.0f); }
                    bf16_t* dst = (bf16_t*)((char*)Mg + ((size_t)(row >> 7) * (DM / 64) + (col >> 6)) * HTB + lds_byte(row & 127, col & 63));
                    if (SECOND) { f32x4 p0, p1; unpack8(*(const u32x4*)dst, p0, p1); v0 += p0; v1 += p1; }
                    *(u32x4*)dst = pack8(v0, v1); } }
    }
};
struct EpiOut { const float* x; bf16_t* x1b; bf16_t* x1s; const float* mod; const float* g2; float* ssq2;
    __device__ __forceinline__ void operator()(AccRef acc, const Unit& u, int wr, int wc, int fr, int fq) const {
        EPI_ROWS(u)
        const int bt = u.pm / 33; const float* mb = mod + bt * 6144;
        f32x4 gt[2][2], sc[2][2];
#pragma unroll
        for (int bj = 0; bj < 2; ++bj)
#pragma unroll
            for (int n = 0; n < 2; ++n) { const int col = EPI_COL(bj) + 4 * n; gt[bj][n] = *(const f32x4*)(mb + 2048 + col);
                const f32x4 g = *(const f32x4*)(g2 + col), s2 = *(const f32x4*)(mb + 4096 + col); sc[bj][n] = g * (s2 + 1.0f); }
#pragma unroll
        for (int ai = 0; ai < 2; ++ai)
#pragma unroll
            for (int m = 0; m < 4; ++m) { const int row = EPI_ROW(ai, m); const size_t lat = (size_t)(row - CTXL * (bt + 1)); float s = 0.f;
#pragma unroll
                for (int bj = 0; bj < 2; ++bj) { const int col = EPI_COL(bj); const size_t off = lat * DM + col;
                    const f32x4 x0 = *(const f32x4*)(x + off), x1 = *(const f32x4*)(x + off + 4);
                    const f32x4 v0 = x0 + gt[bj][0] * acc[ai][bj][m][0], v1 = x1 + gt[bj][1] * acc[ai][bj][m][1];
                    *(u32x4*)(x1b + (size_t)row * DM + col) = pack8(v0, v1);
                    s += (v0[0] * v0[0] + v0[1] * v0[1]) + (v0[2] * v0[2] + v0[3] * v0[3]) + (v1[0] * v1[0] + v1[1] * v1[1]) + (v1[2] * v1[2] + v1[3] * v1[3]);
                    *(u32x4*)((char*)x1s + ((size_t)(row >> 7) * (DM / 64) + (col >> 6)) * HTB + lds_byte(row & 127, col & 63)) = pack8(v0 * sc[bj][0], v1 * sc[bj][1]); }
                s += __shfl_xor(s, 16); s += __shfl_xor(s, 32); if (fq == 0) unsafeAtomicAdd(ssq2 + row, s); }
    }
};
struct EpiUp { bf16_t* U; const float* ssq2; const float* bias2;
    __device__ __forceinline__ void operator()(AccRef acc, const Unit& u, int wr, int wc, int fr, int fq) const {
        EPI_ROWS(u)
        const int bt = u.pm / 33; f32x4 bs[2][2];
#pragma unroll
        for (int bj = 0; bj < 2; ++bj)
#pragma unroll
            for (int n = 0; n < 2; ++n) bs[bj][n] = *(const f32x4*)(bias2 + bt * DFF + EPI_COL(bj) + 4 * n);
#pragma unroll
        for (int ai = 0; ai < 2; ++ai)
#pragma unroll
            for (int m = 0; m < 4; ++m) { const int row = EPI_ROW(ai, m); const float rstd = 1.0f / sqrtf(ssq2[row] * (1.0f / 1024.0f) + EPS);
#pragma unroll
                for (int bj = 0; bj < 2; ++bj) { f32x4 v0 = acc[ai][bj][m][0] * rstd + bs[bj][0], v1 = acc[ai][bj][m][1] * rstd + bs[bj][1];
#pragma unroll
                    for (int i = 0; i < 4; ++i) { const float a = fmaxf(v0[i], 0.f), b = fmaxf(v1[i], 0.f); v0[i] = a * a; v1[i] = b * b; }
                    { const int c_ = EPI_COL(bj);
                      *(u32x4*)((char*)U + ((size_t)(row >> 7) * (DFF / 64) + (c_ >> 6)) * HTB + lds_byte(row & 127, c_ & 63)) = pack8(v0, v1); } } }
    }
};
struct EpiDown { float* out; const bf16_t* x1b; const float* mod; const float* fg; float* xbuf; unsigned* cnt; LAS unsigned char* lx;
    __device__ __forceinline__ void operator()(AccRef acc, const Unit& u, int wr, int wc, int fr, int fq) const {
        EPI_ROWS(u)
        const int bt = u.pm / 33; const float* mb = mod + bt * 6144;
        const int tid = threadIdx.x, wid = __builtin_amdgcn_readfirstlane(tid >> 6), lane = tid & 63;
        LAS float* P = (LAS float*)lx; LAS float* S = (LAS float*)(lx + 4096); volatile LAS unsigned* flag = (volatile LAS unsigned*)(lx + 5120);
        {   f32x4 gt[2][2];
#pragma unroll
            for (int bj = 0; bj < 2; ++bj)
#pragma unroll
                for (int n = 0; n < 2; ++n) gt[bj][n] = *(const f32x4*)(mb + 5120 + EPI_COL(bj) + 4 * n);
#pragma unroll
            for (int ai = 0; ai < 2; ++ai)
#pragma unroll
                for (int m = 0; m < 4; ++m) { const int row = EPI_ROW(ai, m); const size_t lat = (size_t)(row - CTXL * (bt + 1)); float s = 0.f;
#pragma unroll
                    for (int bj = 0; bj < 2; ++bj) { const size_t off = lat * DM + EPI_COL(bj);
                        f32x4 x0, x1; unpack8(*(const u32x4*)(x1b + (size_t)row * DM + EPI_COL(bj)), x0, x1);
                        const f32x4 v0 = x0 + gt[bj][0] * acc[ai][bj][m][0], v1 = x1 + gt[bj][1] * acc[ai][bj][m][1];
                        s += (v0[0] * v0[0] + v0[1] * v0[1]) + (v0[2] * v0[2] + v0[3] * v0[3]) + (v1[0] * v1[0] + v1[1] * v1[1]) + (v1[2] * v1[2] + v1[3] * v1[3]);
                        acc[ai][bj][m][0] = v0; acc[ai][bj][m][1] = v1; }
                    s += __shfl_xor(s, 16); s += __shfl_xor(s, 32);
                    if (fq == 0) P[(ai * HALF + wr * 64 + m * 16 + fr) * 4 + wc] = s;
                    asm volatile("" ::: "memory"); }
        }
        asm volatile("s_waitcnt lgkmcnt(0)" ::: "memory"); __builtin_amdgcn_s_barrier(); asm volatile("" ::: "memory");
        float* slot = xbuf + ((size_t)(u.rnd * (MEXT / 256) + u.pm) * 256) * 4;
        unsigned* cw = cnt + u.rnd * (MEXT / 256) + u.pm;
        if (tid < 256) { const float t4 = (P[tid * 4 + 0] + P[tid * 4 + 1]) + (P[tid * 4 + 2] + P[tid * 4 + 3]);
            __hip_atomic_store(slot + tid * 4 + u.pn, t4, __ATOMIC_RELAXED, __HIP_MEMORY_SCOPE_AGENT);
            asm volatile("s_waitcnt vmcnt(0)" ::: "memory");
            if (lane == 0) __hip_atomic_fetch_add(cw, 1u, __ATOMIC_RELAXED, __HIP_MEMORY_SCOPE_AGENT); }
        if (wid == 0) {
            unsigned sp = 0; bool dead = false;
            for (;;) { if ((unsigned)__builtin_amdgcn_readfirstlane(__hip_atomic_load(cw, __ATOMIC_RELAXED, __HIP_MEMORY_SCOPE_AGENT)) >= 16u) break;
                if (++sp > (1u << 22)) { dead = true; break; } __builtin_amdgcn_s_sleep(2); }
            __builtin_amdgcn_fence(__ATOMIC_ACQUIRE, "agent");
            if (lane == 0) flag[0] = dead ? 1u : 0u;
        }
        asm volatile("s_waitcnt vmcnt(0) lgkmcnt(0)" ::: "memory"); __builtin_amdgcn_s_barrier(); asm volatile("" ::: "memory");
        const bool bad = flag[0] != 0u;
        if (tid < 256) { float t4 = 0.f;
#pragma unroll
            for (int t = 0; t < 4; ++t) t4 += __hip_atomic_load(slot + tid * 4 + t, __ATOMIC_RELAXED, __HIP_MEMORY_SCOPE_AGENT);
            S[tid] = bad ? __builtin_nanf("") : 1.0f / sqrtf(t4 * (1.0f / DM) + EPS); }
        asm volatile("s_waitcnt vmcnt(0) lgkmcnt(0)" ::: "memory"); __builtin_amdgcn_s_barrier(); asm volatile("" ::: "memory");
        {   f32x4 fgv[2][2];
#pragma unroll
            for (int bj = 0; bj < 2; ++bj)
#pragma unroll
                for (int n = 0; n < 2; ++n) fgv[bj][n] = *(const f32x4*)(fg + EPI_COL(bj) + 4 * n);
#pragma unroll
            for (int ai = 0; ai < 2; ++ai)
#pragma unroll
                for (int m = 0; m < 4; ++m) { const int rl = ai * HALF + wr * 64 + m * 16 + fr; const float rs = S[rl]; const size_t lat = (size_t)(EPI_ROW(ai, m) - CTXL * (bt + 1));
#pragma unroll
                    for (int bj = 0; bj < 2; ++bj) { const size_t off = lat * DM + EPI_COL(bj);
                        *(f32x4*)(out + off) = acc[ai][bj][m][0] * rs * fgv[bj][0]; *(f32x4*)(out + off + 4) = acc[ai][bj][m][1] * rs * fgv[bj][1]; } }
        }
        asm volatile("s_waitcnt lgkmcnt(0)" ::: "memory"); __builtin_amdgcn_s_barrier(); asm volatile("" ::: "memory");
    }
};
}

namespace att {
using bf16 = __hip_bfloat16;
constexpr int NW = 8, QBLK = 32, KVBLK = 64;
constexpr float SCALE = 0.10206207261596575f;
constexpr float THR = 8.f;
constexpr int LDQ = QW, LDK = QKD, LDV = 64, LDO = VW;
constexpr int NSLOT = 3, KSLOT = 12288, VSLOT = 8192;
constexpr int LDS_K = 0, LDS_V = NSLOT * KSLOT, LDS_WS = LDS_V + NSLOT * VSLOT, SHM_ATTN = LDS_WS + NW * 64 * 4;
#define SBAR() __builtin_amdgcn_sched_barrier(0)
__device__ __forceinline__ int crow(int r, int hi) { return (r & 3) + 8 * (r >> 2) + 4 * hi; }
__device__ __forceinline__ unsigned cvtpk(float lo, float hi) { unsigned r; asm volatile("v_cvt_pk_bf16_f32 %0, %1, %2" : "=v"(r) : "v"(lo), "v"(hi)); return r; }
__device__ __forceinline__ bf16x8 ld8(const bf16* p) { return *reinterpret_cast<const bf16x8*>(p); }
__device__ __forceinline__ void glds16(const void* gsrc, unsigned lds_dst) { unsigned keep;
  asm volatile("s_mov_b32 %0, m0\n\ts_mov_b32 m0, %2\n\ts_nop 0\n\tglobal_load_lds_dwordx4 %1, off\n\ts_mov_b32 m0, %0" : "=&s"(keep) : "v"(gsrc), "s"(lds_dst) : "memory"); }

__device__ __forceinline__ void glds16s(unsigned voff, const void* sbase, unsigned lds_dst) { unsigned keep;
  asm volatile("s_mov_b32 %0, m0\n\ts_mov_b32 m0, %3\n\ts_nop 0\n\tglobal_load_lds_dwordx4 %1, %2\n\ts_mov_b32 m0, %0" : "=&s"(keep) : "v"(voff), "s"(sbase), "s"(lds_dst) : "memory"); }
__device__ __forceinline__ float rowmax32(const f32x16& p0, const f32x16& p1) {
  float pmax = p0[0];
#pragma unroll
  for (int r = 1; r < 16; ++r) pmax = fmaxf(pmax, p0[r]);
#pragma unroll
  for (int r = 0; r < 16; ++r) pmax = fmaxf(pmax, p1[r]);
  auto rr = __builtin_amdgcn_permlane32_swap(__float_as_uint(pmax), __float_as_uint(pmax), false, false);
  return fmaxf(__uint_as_float(rr[0]), __uint_as_float(rr[1]));
}
constexpr float THR2 = THR * 1.4426950408889634f;
__device__ __forceinline__ void decide(const f32x16& p0, const f32x16& p1, float& mhat, f32x16& negm, float& alpha) {
  const float pmax = rowmax32(p0, p1);
  if (__builtin_expect(__all(pmax <= THR2), 1)) { alpha = 1.f; }
  else { const float dl = fmaxf(pmax, 0.f); mhat += dl;
#pragma unroll
    for (int r = 0; r < 16; ++r) negm[r] = -mhat;
    alpha = __builtin_amdgcn_exp2f(-dl); }
}
__device__ __forceinline__ void guard(float ps, float& mhat, f32x16& negm, float& alpha) {
  constexpr float BIG = 1073741824.f;
  if (__builtin_expect(__all(ps <= BIG), 1)) { alpha = 1.f; }
  else { mhat += 30.f;
#pragma unroll
    for (int r = 0; r < 16; ++r) negm[r] = -mhat;
    alpha = 9.313225746154785e-10f; }
}
__device__ __forceinline__ void exps32(f32x16& p0, f32x16& p1) {
#pragma unroll
  for (int r = 0; r < 16; ++r) p0[r] = __builtin_amdgcn_exp2f(p0[r]);
#pragma unroll
  for (int r = 0; r < 16; ++r) p1[r] = __builtin_amdgcn_exp2f(p1[r]);
}
__device__ __forceinline__ void finishP(const f32x16& p0, const f32x16& p1, float alpha, float& l_reg, bf16x8& pa0, bf16x8& pa1, bf16x8& pa2, bf16x8& pa3, float& ps_out) {
  float ps = 0, ps2 = 0;
#pragma unroll
  for (int r = 0; r < 16; ++r) ps += p0[r];
#pragma unroll
  for (int r = 0; r < 16; ++r) ps2 += p1[r];
  ps += ps2;
  l_reg = (l_reg + ps) * alpha; ps_out = ps;
#define PK4(P, BASE, OUT) do { unsigned a0 = cvtpk(P[BASE + 0], P[BASE + 1]), a1 = cvtpk(P[BASE + 2], P[BASE + 3]);   \
    unsigned b0 = cvtpk(P[BASE + 4], P[BASE + 5]), b1 = cvtpk(P[BASE + 6], P[BASE + 7]);                              \
    u32x4 w = {a0, a1, b0, b1}; OUT = *reinterpret_cast<bf16x8*>(&w); } while (0)
  PK4(p0, 0, pa0); PK4(p0, 8, pa1); PK4(p1, 0, pa2); PK4(p1, 8, pa3);
#undef PK4
}
__device__ __forceinline__ void qkt(f32x16& p0, f32x16& p1, const char* Ks, const bf16x8* qr, const f32x16& negm) {
#pragma unroll
  for (int d0 = 0; d0 < 6; ++d0) {
    bf16x8 b0 = *reinterpret_cast<const bf16x8*>(Ks + d0 * 2048);
    bf16x8 b1 = *reinterpret_cast<const bf16x8*>(Ks + d0 * 2048 + 512);
    if (d0 == 0) { p0 = __builtin_amdgcn_mfma_f32_32x32x16_bf16(b0, qr[0], negm, 0, 0, 0); p1 = __builtin_amdgcn_mfma_f32_32x32x16_bf16(b1, qr[0], negm, 0, 0, 0); }
    else { p0 = __builtin_amdgcn_mfma_f32_32x32x16_bf16(b0, qr[d0], p0, 0, 0, 0); p1 = __builtin_amdgcn_mfma_f32_32x32x16_bf16(b1, qr[d0], p1, 0, 0, 0); } }
}
__device__ __forceinline__ int v_rd_base(int lane) { return ((lane & 3) << 3) | (((lane >> 2) & 3) << 6) | (((lane >> 4) & 1) << 5) | (((lane >> 5) & 1) << 8); }
constexpr int v_rd_off(int d0, int ks, int half) { return d0 * 512 + ks * 2048 + half * 1024; }
template <int OFF> __device__ __forceinline__ s16x4 tr_read(int vb) {
  s16x4 r; asm volatile("ds_read_b64_tr_b16 %0, %1 offset:%2" : "=&v"(r) : "v"(vb), "i"(OFF) : "memory"); return r;
}
struct VF { s16x4 l[2][4], h[2][4]; };
__device__ __forceinline__ void v_read(VF& f, int vb) {
#define VR(D0, KS) f.l[D0][KS] = tr_read<v_rd_off(D0, KS, 0)>(vb); f.h[D0][KS] = tr_read<v_rd_off(D0, KS, 1)>(vb);
  VR(0, 0) VR(0, 1) VR(0, 2) VR(0, 3) VR(1, 0) VR(1, 1) VR(1, 2) VR(1, 3)
#undef VR
}
__device__ __forceinline__ void v_wait(VF& f) {
  asm volatile("s_waitcnt lgkmcnt(0)" : "+v"(f.l[0][0]), "+v"(f.l[0][1]), "+v"(f.l[0][2]), "+v"(f.l[0][3]), "+v"(f.h[0][0]), "+v"(f.h[0][1]), "+v"(f.h[0][2]), "+v"(f.h[0][3]),
               "+v"(f.l[1][0]), "+v"(f.l[1][1]), "+v"(f.l[1][2]), "+v"(f.l[1][3]), "+v"(f.h[1][0]), "+v"(f.h[1][1]), "+v"(f.h[1][2]), "+v"(f.h[1][3]) :: "memory");
}
__device__ __forceinline__ void pv_mma(f32x16* o, const VF& f, bf16x8 pa0, bf16x8 pa1, bf16x8 pa2, bf16x8 pa3) {
#define PK(L, H) (bf16x8){L[0], L[1], L[2], L[3], H[0], H[1], H[2], H[3]}
#pragma unroll
  for (int d = 0; d < 2; ++d) {
    o[d] = __builtin_amdgcn_mfma_f32_32x32x16_bf16(pa0, PK(f.l[d][0], f.h[d][0]), o[d], 0, 0, 0);
    o[d] = __builtin_amdgcn_mfma_f32_32x32x16_bf16(pa1, PK(f.l[d][1], f.h[d][1]), o[d], 0, 0, 0);
    o[d] = __builtin_amdgcn_mfma_f32_32x32x16_bf16(pa2, PK(f.l[d][2], f.h[d][2]), o[d], 0, 0, 0);
    o[d] = __builtin_amdgcn_mfma_f32_32x32x16_bf16(pa3, PK(f.l[d][3], f.h[d][3]), o[d], 0, 0, 0); }
#undef PK
}

__device__ __forceinline__ void attn_unit(const bf16* __restrict__ Qb, const bf16* __restrict__ Kh, const bf16* __restrict__ Vh, bf16* __restrict__ Ob, int seq, char* lds, const float* __restrict__ tab, int t0) {
  int tid_ = threadIdx.x; asm volatile("" : "+v"(tid_));
  const int tid = tid_, lane = tid & 63, r32 = lane & 31, hi = lane >> 5; const int wid = __builtin_amdgcn_readfirstlane(tid >> 6);
  const unsigned lds0 = (unsigned)(uintptr_t)lds;
  float* ws = (float*)(lds + LDS_WS) + wid * 64; float* li_l = ws; float* al_l = ws + 32;
  float mhat = 0.f, l_reg = 0; f32x16 o[2] = {}; bf16x8 qr[6]; f32x16 negm = f32x16{}; asm volatile("" : "+v"(negm));
  const bf16* Qw = Qb + (long)(wid * QBLK + r32) * LDQ + hi * 8;
#pragma unroll
  for (int d0 = 0; d0 < 6; ++d0) qr[d0] = ld8(Qw + d0 * 16);
  { const int tq = t0 + wid * QBLK + r32;
#pragma unroll
    for (int part = 0; part < 2; ++part) { const int pos = part ? (tq & 63) : (tq >> 6); const float* tp = tab + pos * 16 + hi * 8;
      const f32x4 c0 = *(const f32x4*)tp, c1 = *(const f32x4*)(tp + 4);
      const f32x4 cs = (f32x4){c0[0], c0[2], c1[0], c1[2]}, sn = (f32x4){c0[1], c0[3], c1[1], c1[3]};
      const u32x4 w = __builtin_bit_cast(u32x4, qr[4 + part]); f32x4 x1, x2; unpack8(w, x1, x2);
      qr[4 + part] = __builtin_bit_cast(bf16x8, pack8(x1 * cs - x2 * sn, x1 * sn + x2 * cs)); } }
  const bool k2 = wid < 4;
  const unsigned koffA = (unsigned)(wid * 512 + lane * 8) * 2u, koffB = (unsigned)((8 + (wid & 3)) * 512 + lane * 8) * 2u;
  const int vkk = wid * 8 + ((lane >> 2) & 7), vkey = vkk;
  const unsigned voffV = (unsigned)(vkey * LDV + (lane >> 5) * 32 + (lane & 3) * 8) * 2u;
  const unsigned kdstA = lds0 + LDS_K + wid * 1024, kdstB = lds0 + LDS_K + (8 + (wid & 3)) * 1024, vdst = lds0 + LDS_V + wid * 1024;
#define DMA_K(t, slot) do { const bf16* kb_ = Kh + (long)(t) * KVBLK * LDK; glds16s(koffA, kb_, (unsigned)__builtin_amdgcn_readfirstlane(kdstA + (slot) * KSLOT)); \
    if (k2) glds16s(koffB, kb_, (unsigned)__builtin_amdgcn_readfirstlane(kdstB + (slot) * KSLOT)); } while (0)
#define DMA_V(t, slot) glds16s(voffV, Vh + (long)(t) * KVBLK * LDV, (unsigned)__builtin_amdgcn_readfirstlane(vdst + (slot) * VSLOT))
#define WAIT_ALL_BAR() asm volatile("s_waitcnt vmcnt(0) lgkmcnt(0)\n\ts_barrier" ::: "memory")
#define WAIT_STEP_BAR() do { if (k2) asm volatile("s_waitcnt vmcnt(3) lgkmcnt(0)\n\ts_barrier" ::: "memory"); else asm volatile("s_waitcnt vmcnt(2) lgkmcnt(0)\n\ts_barrier" ::: "memory"); } while (0)
#define RESC(a) do { if (__any((a) < 1.f)) { \
    _Pragma("unroll") for (int d = 0; d < 2; ++d) _Pragma("unroll") for (int r = 0; r < 16; ++r) o[d][r] *= (a); } } while (0)
  const char* kp0 = lds + LDS_K + hi * 1024 + r32 * 16;
  const int vb0 = (int)(lds0 + LDS_V) + v_rd_base(lane);
  f32x16 pA0, pA1, pB0, pB1; float alA, alB, psum; bf16x8 pa0, pa1, pa2, pa3; VF vf; const int NT = seq / KVBLK;
  int s_prev = 2, s_cur = 0, s_next = 1;
#define ROT() do { const int t_ = s_prev; s_prev = s_cur; s_cur = s_next; s_next = t_; } while (0)
#define STEP(N0, N1, O0, O1, alN, alO, t) do { \
    const bool full_ = (t) + 2 < NT; \
    qkt(N0, N1, kp0 + s_cur * KSLOT, qr, negm); \
    finishP(O0, O1, alO, l_reg, pa0, pa1, pa2, pa3, psum); \
    _Pragma("unroll") for (int g_ = 0; g_ < 12; ++g_) { __builtin_amdgcn_sched_group_barrier(0x008, 1, 0); __builtin_amdgcn_sched_group_barrier(0x002, 5, 0); } \
    v_read(vf, vb0 + s_prev * VSLOT);     \
    if (full_) DMA_K((t) + 2, s_prev); if ((t) + 1 < NT) DMA_V((t) + 1, s_next);     \
    guard(psum, mhat, negm, alN); v_wait(vf); \
    pv_mma(o, vf, pa0, pa1, pa2, pa3); exps32(N0, N1); asm volatile("" : "+v"(N0), "+v"(N1)); \
    _Pragma("unroll") for (int g_ = 0; g_ < 8; ++g_) { __builtin_amdgcn_sched_group_barrier(0x008, 1, 0); __builtin_amdgcn_sched_group_barrier(0x002, 4, 0); } \
    RESC(alO); \
    if (full_) WAIT_STEP_BAR(); else WAIT_ALL_BAR(); \
    ROT(); } while (0)
  DMA_K(0, 0); DMA_V(0, 0); DMA_K(1, 1);
  WAIT_ALL_BAR();
  DMA_K(2, 2); DMA_V(1, 1);
  qkt(pA0, pA1, kp0, qr, negm);
  { const float dl = rowmax32(pA0, pA1); mhat = dl;
#pragma unroll
    for (int r = 0; r < 16; ++r) { pA0[r] -= dl; pA1[r] -= dl; }
#pragma unroll
    for (int r = 0; r < 16; ++r) negm[r] = -mhat;
    asm volatile("" : "+v"(negm)); alA = 1.f; }
  exps32(pA0, pA1); asm volatile("" : "+v"(pA0), "+v"(pA1));
  WAIT_ALL_BAR(); ROT();
  int t = 1;
  for (; t + 1 < NT; t += 2) {
    STEP(pB0, pB1, pA0, pA1, alB, alA, t);
    STEP(pA0, pA1, pB0, pB1, alA, alB, t + 1);
  }
  STEP(pB0, pB1, pA0, pA1, alB, alA, t);
  v_read(vf, vb0 + s_prev * VSLOT);
  finishP(pB0, pB1, 1.f, l_reg, pa0, pa1, pa2, pa3, psum); v_wait(vf);
  pv_mma(o, vf, pa0, pa1, pa2, pa3);
  { auto rr = __builtin_amdgcn_permlane32_swap(__float_as_uint(l_reg), __float_as_uint(l_reg), false, false); l_reg = __uint_as_float(rr[0]) + __uint_as_float(rr[1]); }
  if (hi == 0) li_l[r32] = l_reg; asm volatile("s_waitcnt lgkmcnt(0)" ::: "memory");
  float rli[16];
#pragma unroll
  for (int r = 0; r < 16; ++r) rli[r] = __builtin_amdgcn_rcpf(li_l[crow(r, hi)]);
  bf16* Ow = Ob + (long)(wid * QBLK) * LDO;
#pragma unroll
  for (int r = 0; r < 16; ++r) { int orow = crow(r, hi);
#pragma unroll
    for (int d0 = 0; d0 < 2; ++d0) Ow[(long)orow * LDO + d0 * 32 + r32] = __float2bfloat16(o[d0][r] * rli[r]); }
  asm volatile("s_waitcnt vmcnt(0) lgkmcnt(0)\n\ts_barrier" ::: "memory");
#undef DMA_K
#undef DMA_V
#undef WAIT_ALL_BAR
#undef WAIT_STEP_BAR
#undef RESC
#undef ROT
#undef STEP
}
#undef SBAR
}


#define XB_TMO      128
#define XB_XCNT(j)  (256  + 64 * (j))
#define XB_XSUB(j)  (1280 + 64 * (j))
#define XB_XGEN(j)  (2304 + 64 * (j))
#define XB_TOP      3328
#define XB_TOPGEN   3392
#define XCD_BAR_WORDS 3456
#define XB_SPIN_CAP (1u << 22)
__device__ __forceinline__ unsigned xb_ld(unsigned* p)              { return __hip_atomic_load(p, __ATOMIC_RELAXED, __HIP_MEMORY_SCOPE_AGENT); }
__device__ __forceinline__ unsigned xb_add(unsigned* p, unsigned v) { return __hip_atomic_fetch_add(p, v, __ATOMIC_RELAXED, __HIP_MEMORY_SCOPE_AGENT); }
__device__ __forceinline__ unsigned xb_xcc_id() { return (unsigned)__builtin_amdgcn_s_getreg((3 << 11) | 20) & 0xFu; }
#define XB_SPIN(cond, bar) do { unsigned _sp = 0; while (cond) { __builtin_amdgcn_s_sleep(1); \
    if ((++_sp & 255u) == 0u) { if (xb_ld(&(bar)[XB_TMO])) break; if (_sp > XB_SPIN_CAP) { atomicAdd(&(bar)[XB_TMO], 1u); break; } } } } while (0)
struct XcdBarrier { unsigned* bar; unsigned x; volatile LAS unsigned* st; };
__device__ __forceinline__ XcdBarrier xcd_barrier_post(unsigned* bar, volatile LAS unsigned* st) {
    XcdBarrier b; b.bar = bar; b.x = xb_xcc_id(); b.st = st;
    if (threadIdx.x == 0) (void)xb_add(&bar[XB_XCNT(b.x)], 1u);
    return b;
}
__device__ __forceinline__ void xcd_barrier_complete(unsigned* bar, unsigned x, unsigned& nloc, unsigned& nx) {
    const unsigned G = gridDim.x * gridDim.y * gridDim.z;
    unsigned sum, cnt, mine, sp = 0u;
    for (;;) {
        sum = 0u; cnt = 0u; mine = 0u;
#pragma unroll
        for (unsigned j = 0; j < 16; ++j) { const unsigned c = xb_ld(&bar[XB_XCNT(j)]); sum += c; cnt += (c > 0u) ? 1u : 0u; mine = (j == x) ? c : mine; }
        if (sum == G) break;
        __builtin_amdgcn_s_sleep(1);
        if ((++sp & 255u) == 0u) { if (xb_ld(&bar[XB_TMO])) break; if (sp > XB_SPIN_CAP) { atomicAdd(&bar[XB_TMO], 1u); break; } }
    }
    nloc = mine > 0u ? mine : 1u; nx = cnt > 0u ? cnt : 1u;
}
__device__ __forceinline__ void xcd_barrier(const XcdBarrier& b) {
    asm volatile("s_waitcnt vmcnt(0)" ::: "memory");
    __syncthreads();
    if (threadIdx.x == 0) {
        unsigned* bar = b.bar;
        __builtin_amdgcn_s_waitcnt(0);
        unsigned nloc = b.st[0], nx = b.st[1];
        if (nloc == 0u) { xcd_barrier_complete(bar, b.x, nloc, nx); b.st[0] = nloc; b.st[1] = nx; }
        const unsigned old = xb_add(&bar[XB_XSUB(b.x)], 1u);
        const unsigned gen = old / nloc;
        if (old + 1u == (gen + 1u) * nloc) {
            __builtin_amdgcn_fence(__ATOMIC_RELEASE, "agent");
            asm volatile("s_waitcnt vmcnt(0)" ::: "memory");
            const unsigned og = xb_add(&bar[XB_TOP], 1u);
            const unsigned tg = og / nx;
            if (og + 1u == (tg + 1u) * nx) xb_add(&bar[XB_TOPGEN], 1u);
            else XB_SPIN(xb_ld(&bar[XB_TOPGEN]) == tg, bar);
            __builtin_amdgcn_fence(__ATOMIC_ACQUIRE, "agent");
            xb_add(&bar[XB_XGEN(b.x)], 1u);
            asm volatile("s_waitcnt vmcnt(0)" ::: "memory");
        } else {
            XB_SPIN(xb_ld(&bar[XB_XGEN(b.x)]) == gen, bar);
            __builtin_amdgcn_fence(__ATOMIC_ACQUIRE, "agent");
            asm volatile("s_waitcnt vmcnt(0)" ::: "memory");
        }
    }
    __syncthreads();
}

template <class RowMap>
__device__ __forceinline__ void transpose_item(const float* W, int K, int N, bf16_t* WT, LAS float* scr, int item, int lane, const float* kscale, RowMap rm) {
    const int nblk = N / 32, kb = item / nblk, nb = item % nblk, k0 = 64 * kb, n0 = 32 * nb;
#pragma unroll 8
    for (int i = 0; i < 32; ++i) { const int kk = 2 * i + (lane >> 5); float v = W[(size_t)(k0 + kk) * N + n0 + (lane & 31)]; if (kscale) v *= kscale[k0 + kk]; scr[kk * 33 + (lane & 31)] = v; }
    asm volatile("s_waitcnt lgkmcnt(0)" ::: "memory");
    const int c = lane & 7;
#pragma unroll
    for (int j = 0; j < 4; ++j) { const int n = (lane >> 3) + 8 * j; const LAS float* s = scr + (8 * c) * 33 + n;
        u32x4 o; o.x = cvt_pk_bf16(s[0 * 33], s[1 * 33]); o.y = cvt_pk_bf16(s[2 * 33], s[3 * 33]); o.z = cvt_pk_bf16(s[4 * 33], s[5 * 33]); o.w = cvt_pk_bf16(s[6 * 33], s[7 * 33]);
        *(u32x4*)(WT + (size_t)rm(n0 + n) * K + k0 + 8 * c) = o; }
    asm volatile("s_waitcnt lgkmcnt(0)" ::: "memory");
}
template <int NR>
__device__ __forceinline__ void gemv_item(const float* W, int N, const LAS float* sv, float* dst, const float* bias, int cgp, int ks, int lane) {
    const int col = cgp * 256 + lane * 4; f32x4 acc[NR];
#pragma unroll
    for (int b = 0; b < NR; ++b) acc[b] = (f32x4){0.f, 0.f, 0.f, 0.f};
    const float* wp = W + (size_t)(ks * 128) * N + col;
#pragma unroll 4
    for (int k = 0; k < 128; ++k) { const f32x4 w = *(const f32x4*)(wp + (size_t)k * N);
#pragma unroll
        for (int b = 0; b < NR; ++b) acc[b] += w * sv[b * 1024 + ks * 128 + k]; }
#pragma unroll
    for (int b = 0; b < NR; ++b) { if (bias && ks == 0) acc[b] += *(const f32x4*)(bias + col);
#pragma unroll
        for (int i = 0; i < 4; ++i) unsafeAtomicAdd(dst + (size_t)b * N + col + i, acc[b][i]); }
}

__global__ void __launch_bounds__(512, 2) fwd(Args a) {
    extern __shared__ __attribute__((aligned(16))) unsigned char lds_raw[];
    LAS unsigned char* lds = (LAS unsigned char*)lds_raw;
    const int tid = threadIdx.x, lane = tid & 63, wave = __builtin_amdgcn_readfirstlane(tid >> 6);
    const int G = gridDim.x, bx = blockIdx.x, gw = bx * 8 + wave, NGW = G * 8;
    unsigned char* ws = a.ws;
    float* mod = (float*)(ws + WS_MOD); float* bias2 = (float*)(ws + WS_BIAS2);
    float* ssq_q = (float*)(ws + WS_SSQQ); float* ssq_kv = (float*)(ws + WS_SSQKV); float* ssq2 = (float*)(ws + WS_SSQ2); float* ssq3 = (float*)(ws + WS_SSQ3);
    float* tab = (float*)(ws + WS_TAB);
    bf16_t* WinT = (bf16_t*)(ws + WS_WIN); bf16_t* WuqT = (bf16_t*)(ws + WS_WUQ); bf16_t* WukvT = (bf16_t*)(ws + WS_WUKV); bf16_t* WbmT = (bf16_t*)(ws + WS_WBM);
    bf16_t* WppT = (bf16_t*)(ws + WS_WPP); bf16_t* WoutT = (bf16_t*)(ws + WS_WOUT); bf16_t* W1T = (bf16_t*)(ws + WS_W1); bf16_t* W2T = (bf16_t*)(ws + WS_W2);
    bf16_t* Hb = (bf16_t*)(ws + WS_H); bf16_t* Qb = (bf16_t*)(ws + WS_Q); bf16_t* Kb = (bf16_t*)(ws + WS_K); bf16_t* Vb = (bf16_t*)(ws + WS_V); bf16_t* Mg = (bf16_t*)(ws + WS_MERGED);
    bf16_t* Dp = (bf16_t*)(ws + WS_DPOOL); bf16_t* At = (bf16_t*)(ws + WS_ATTN); bf16_t* X1s = (bf16_t*)(ws + WS_X1S);
    bf16_t* X1b = (bf16_t*)(ws + WS_R1 + 132 * MiB);
    unsigned char* G8b = ws + WS_G8;
    bf16_t* Yb = (bf16_t*)(ws + WS_Y); bf16_t* Ub = (bf16_t*)(ws + WS_U);
    const int lo = a.ph_lo, hi_ph = a.ph_hi;
#if MK_COOP
    volatile LAS unsigned* bst = (volatile LAS unsigned*)(lds + LDS_BYTES - 64);
    if (tid < 16) bst[tid] = 0u;
    __syncthreads();
    XcdBarrier bar = xcd_barrier_post((unsigned*)(ws + WS_BAR), bst);
    if (lo < 0) cg::this_grid().sync();
#endif
#ifndef PHMASK
#define PHMASK 0x1ff
#endif
#define IN(k) (((PHMASK >> (k)) & 1) && lo <= (k) && (k) < hi_ph)
#if MK_COOP
#define SEAM(k) do { if (IN(k) && IN((k) + 1)) xcd_barrier(bar); } while (0)
#else
#define SEAM(k) do { } while (0)
#endif

    if (IN(0)) {
        LAS float* sil = (LAS float*)(lds + 73728);
        for (int i = tid; i < 9 * 1024; i += 512) { const int b = i >> 10, k = i & 1023; const float v = (b < 8) ? a.in[1][b * 1024 + k] : a.in[3][k]; sil[i] = v / (1.f + __expf(-v)); }
        __syncthreads();
        LAS float* scr = (LAS float*)(lds + wave * 8448);
        constexpr int I_ADA = 24 * 8, I_PP = 1024, I_IN = 16 * 101, I_UQ = 6 * 24, I_UKV = 4 * 32, I_BM = 8 * 32, I_OUT = 16 * 32, I_W1 = 16 * 128, I_W2 = 64 * 32, I_PAD = 96, I_TAB = 1;
        constexpr int NITEMS = I_ADA + I_PP + I_IN + I_UQ + I_UKV + I_BM + I_OUT + I_W1 + I_W2 + I_PAD + I_TAB;
        auto ident = [](int n) { return n; };
        for (int it = gw; it < NITEMS; it += NGW) {
            int r = it;
            if (r < I_ADA) { gemv_item<9>(a.in[4], 6144, sil, mod, a.in[5], r >> 3, r & 7, lane); continue; } r -= I_ADA;
            if (r < I_PP) {
                const int kc = r >> 4, nb = r & 15, k0 = kc * 8, gI = k0 >> 7, c0 = k0 & 127, n = nb * 64 + lane;
                const float* pw = a.in[13] + (size_t)(gI * 128 + c0) * 128; const float* psc = a.in[14] + gI * 128; const float* wb = a.in[15] + (size_t)(gI * 128) * 1024 + n;
                float ac[8] = {0.f, 0.f, 0.f, 0.f, 0.f, 0.f, 0.f, 0.f};
#pragma unroll 4
                for (int d = 0; d < 128; ++d) { const float wv = wb[(size_t)d * 1024] * psc[d];
#pragma unroll
                    for (int i = 0; i < 8; ++i) ac[i] += pw[i * 128 + d] * wv; }
                u32x4 o; o.x = cvt_pk_bf16(ac[0], ac[1]); o.y = cvt_pk_bf16(ac[2], ac[3]); o.z = cvt_pk_bf16(ac[4], ac[5]); o.w = cvt_pk_bf16(ac[6], ac[7]);
                *(u32x4*)(WppT + (size_t)n * 512 + k0) = o; continue; } r -= I_PP;
            if (r < I_IN) { transpose_item(a.in[7], 1024, 3232, WinT, scr, r, lane, nullptr, [](int n) { return n < 384 ? n : (n < 640 ? n + 128 : (n < 672 ? n - 256 : n + 96)); }); continue; } r -= I_IN;
            if (r < I_UQ) { transpose_item(a.in[10], 384, 768, WuqT, scr, r, lane, a.in[8], [](int n) { const int d = n % 96; if (d < 64) return n; const int p = d - 64, part = p >> 4, half = (p >> 3) & 1, j = p & 7;
                                return n - d + 64 + 8 * (part * 2 + (j >> 2)) + 4 * half + (j & 3); }); continue; } r -= I_UQ;
            if (r < I_UKV) { transpose_item(a.in[11], 256, 1024, WukvT, scr, r, lane, a.in[9], [](int n) { const int h = n >> 7, e = n & 127; return e < 64 ? h * 64 + e : 512 + h * 64 + (e - 64); }); continue; } r -= I_UKV;
            if (r < I_BM) { transpose_item(a.in[12], 512, 1024, WbmT, scr, r, lane, nullptr, ident); continue; } r -= I_BM;
            if (r < I_OUT) { transpose_item(a.in[16], 1024, 1024, WoutT, scr, r, lane, nullptr, ident); continue; } r -= I_OUT;
            if (r < I_W1) { transpose_item(a.in[18], 1024, 4096, W1T, scr, r, lane, nullptr, ident); continue; } r -= I_W1;
            if (r < I_W2) { transpose_item(a.in[19], 4096, 1024, W2T, scr, r, lane, nullptr, ident); continue; } r -= I_W2;
            if (r < I_PAD) { u32x4 z = {0u, 0u, 0u, 0u}; u32x4* p = (u32x4*)(WinT + (size_t)(416 + r) * 1024); p[lane] = z; p[64 + lane] = z; continue; } r -= I_PAD;
            {
                for (int e = lane; e < 1024; e += 64) { const int pos = e >> 3, j = e & 7; const float invf = powf(10000.0f, -(float)(2 * j) / 16.0f); const float ang = (float)pos * invf;
                    tab[2 * e] = cosf(ang); tab[2 * e + 1] = sinf(ang); } }
        }
    }
    SEAM(0);

    if (IN(1)) {
        LAS float* sh2 = (LAS float*)(lds + 73728);
        for (int i = tid; i < 8 * 1024; i += 512) sh2[i] = mod[(i >> 10) * 6144 + 3072 + (i & 1023)];
        __syncthreads();
        if (gw < 128) gemv_item<8>(a.in[18], 4096, sh2, bias2, nullptr, gw >> 3, gw & 7, lane);
        const float* g1 = a.in[6];
        for (int r = gw; r < MEXT; r += NGW) {
            const int b = r / EXT, j = r - b * EXT; const bool isctx = j < CTXL;
            const float* src = isctx ? a.in[2] + (size_t)(b * CTXL + j) * DM : a.in[0] + (size_t)(b * SEQ + j - CTXL) * DM; const float* mb = mod + (isctx ? 8 : b) * 6144;
            f32x4 v[4]; float s = 0.f;
#pragma unroll
            for (int q = 0; q < 4; ++q) { v[q] = *(const f32x4*)(src + 4 * lane + 256 * q); s += (v[q][0] * v[q][0] + v[q][1] * v[q][1]) + (v[q][2] * v[q][2] + v[q][3] * v[q][3]); }
            const float rstd = 1.0f / sqrtf(wave_sum(s) * (1.0f / DM) + EPS);
#pragma unroll
            for (int q = 0; q < 4; ++q) { const int col = 4 * lane + 256 * q; const f32x4 g = *(const f32x4*)(g1 + col), sc = *(const f32x4*)(mb + 1024 + col), sh = *(const f32x4*)(mb + col);
                const f32x4 o = v[q] * rstd * g * (sc + 1.0f) + sh; u32x2 w; w.x = cvt_pk_bf16(o[0], o[1]); w.y = cvt_pk_bf16(o[2], o[3]);
                *(u32x2*)((char*)Hb + ((size_t)(r >> 7) * (DM / 64) + (col >> 6)) * pg8::HTB + pg8::lds_byte(r & 127, col & 63)) = w; }
        }
    }
    SEAM(1);

    if (IN(2)) {
        pg8::Gemm g{Hb, WinT, DM, DM, 1}; pg8::Order S; S.init(MEXT / 256, NWIN / 256, G, bx, 0);
        pg8::EpiY E{Yb, G8b, ssq_q, ssq_kv};
        pg8::gemm_phase(lds, g, S, E);
    }
    SEAM(2);

    if (IN(3)) {
#ifndef NO_P3A
        { pg8::Gemm g{Yb + Y_CQ, WuqT, YW, 384}; pg8::Order S; S.init(MLAT / 256, QW / 256, G, bx, 1);
          pg8::EpiQ E{Qb, ssq_q}; pg8::gemm_phase(lds, g, S, E); }
#endif
#ifndef NO_P3B
        { pg8::Gemm g{Yb + Y_CKV, WukvT, YW, 256}; pg8::Order S; S.init(MEXT / 256, 1024 / 256, G, bx, 0);
          pg8::EpiKV E{Kb, ssq_kv}; pg8::gemm_phase(lds, g, S, E); }
#endif
        const int gt = bx * 512 + tid, NTH = G * 512;
#ifndef NO_P3C
        for (int idx = gt; idx < MEXT * 4; idx += NTH) {
            const int r = idx >> 2, fq = idx & 3, b = r / EXT, j = r - b * EXT, part = fq >> 1, j0 = 4 * (fq & 1);
            const bf16_t* src = Yb + (size_t)r * YW + Y_KR + part * 16 + j0;
            const u32x2 a1 = *(const u32x2*)src, a2 = *(const u32x2*)(src + 8);
            f32x4 x1 = (f32x4){bf_lo(a1.x), bf_hi(a1.x), bf_lo(a1.y), bf_hi(a1.y)}, x2 = (f32x4){bf_lo(a2.x), bf_hi(a2.x), bf_lo(a2.y), bf_hi(a2.y)};
            if (j >= CTXL) { const int t = j - CTXL, pos = part ? (t & 63) : (t >> 6); const float* tp = tab + pos * 16 + j0 * 2;
                const f32x4 t0 = *(const f32x4*)tp, t1 = *(const f32x4*)(tp + 4);
                const f32x4 cs = (f32x4){t0[0], t0[2], t1[0], t1[2]}, sn = (f32x4){t0[1], t0[3], t1[1], t1[3]};
                const f32x4 o1 = x1 * cs - x2 * sn, o2 = x1 * sn + x2 * cs; x1 = o1; x2 = o2; }
            const u32x4 w = pack8(x1, x2);
#pragma unroll
            for (int h = 0; h < NH; ++h) *(u32x4*)(Kb + ((size_t)((b * NH + h) * (EXT / 64) + (j >> 6)) * 12 + 8 + fq) * 512 + (size_t)(j & 63) * 8) = w;
        }
#endif
#ifndef NO_P3D
        for (int idx = gt; idx < (MLAT / 32) * 64; idx += NTH) {
            const int seg = idx >> 6, ch = idx & 63, b = seg >> 8, t0 = (seg & 255) << 5, half = 1 << (ch >> 4);
            const bf16_t* base = Yb + (size_t)(b * EXT + CTXL) * YW + Y_POOL + ch * 8;
            bf16_t* dst = Dp + (size_t)(b * EXT + CTXL) * 512 + ch * 8;
            f32x4 s0 = (f32x4){0.f, 0.f, 0.f, 0.f}, s1 = s0;
            for (int sidx = max(t0 - half, 0); sidx < min(t0 + half, SEQ); ++sidx) { f32x4 p0, p1; unpack8(*(const u32x4*)(base + (size_t)sidx * YW), p0, p1); s0 += p0; s1 += p1; }
#pragma unroll 4
            for (int t = t0; t < t0 + 32; ++t) {
                const int cnt = min(t + half, SEQ) - max(t - half, 0); const float inv = 1.0f / (float)cnt;
                f32x4 c0, c1; unpack8(*(const u32x4*)(base + (size_t)t * YW), c0, c1);
                *(u32x4*)(dst + (size_t)t * 512) = pack8(s0 * inv - c0, s1 * inv - c1);
                if (t + half < SEQ) { f32x4 p0, p1; unpack8(*(const u32x4*)(base + (size_t)(t + half) * YW), p0, p1); s0 += p0; s1 += p1; }
                if (t - half >= 0) { f32x4 p0, p1; unpack8(*(const u32x4*)(base + (size_t)(t - half) * YW), p0, p1); s0 -= p0; s1 -= p1; }
            }
        }
#endif
    }
    SEAM(3);

    if (IN(4)) {
        const int xcd = bx & 7, loc = bx >> 3, per = G >> 3;
        for (int rep = 0; rep < REP4; ++rep)
        for (int i = 0; i < 8; ++i) {
            const int bh = xcd * 8 + i, b = bh >> 3, h = bh & 7;
            for (int qb = loc; qb < 32; qb += per) {
                const size_t krow0 = (size_t)b * EXT, qrow0 = krow0 + CTXL + (size_t)qb * 256;
                att::attn_unit((const att::bf16*)(Qb + qrow0 * QW + h * QKD), (const att::bf16*)(Kb + (size_t)bh * EXT * QKD), (const att::bf16*)(Vb + (size_t)bh * EXT * 64),
                               (att::bf16*)(At + qrow0 * VW + h * 64), EXT, (char*)lds_raw, tab, qb * 256);
            }
        }
    }
    SEAM(4);

    if (IN(5)) {
        { pg8::Gemm g{At, WbmT, 512, 512}; pg8::Order S; S.init(MLAT / 256, 4, G, bx, 1); pg8::EpiMerge<0> E{Mg, G8b}; pg8::gemm_phase(lds, g, S, E); }
        { pg8::Gemm g{Dp, WppT, 512, 512}; pg8::Order S; S.init(MLAT / 256, 4, G, bx, 1); pg8::EpiMerge<1> E{Mg, G8b}; pg8::gemm_phase(lds, g, S, E); }
    }
    SEAM(5);

    if (IN(6)) {
        pg8::Gemm g{Mg, WoutT, DM, DM, 1}; pg8::Order S; S.init(MLAT / 256, 4, G, bx, 1);
        pg8::EpiOut E{a.in[0], X1b, X1s, mod, a.in[17], ssq2}; pg8::gemm_phase(lds, g, S, E);
    }
    SEAM(6);

    if (IN(7)) {
        pg8::Gemm g{X1s, W1T, DM, DM, 1}; pg8::Order S; S.init(MLAT / 256, DFF / 256, G, bx, 1);
        pg8::EpiUp E{Ub, ssq2, bias2}; for (int rep = 0; rep < REP7; ++rep) pg8::gemm_phase(lds, g, S, E);
    }
    SEAM(7);

    if (IN(8)) {
        pg8::Gemm g{Ub, W2T, DFF, DFF, 1}; pg8::Order S; S.init(MLAT / 256, 4, G, bx, 1);
        pg8::EpiDown E{a.out, X1b, mod, a.in[20], (float*)(ws + WS_XBUF), (unsigned*)(ws + WS_XCNT), lds + 131072}; pg8::gemm_phase(lds, g, S, E);
    }
#undef IN
#undef SEAM
}

extern "C" void kernel_launch(void* const* d_in, const int* in_sizes, int n_in, void* d_out, int out_size, void* d_ws, size_t ws_size, hipStream_t stream) {
    static int grid = 0;
    if (grid == 0) {
        if (n_in != 21 || in_sizes[0] != MLAT * DM || out_size != MLAT * DM || ws_size < WS_END) {
            fprintf(stderr, "kernel_launch: shape mismatch n_in %d in0 %d out %d ws %zu (need %zu)\n", n_in, n_in > 0 ? in_sizes[0] : -1, out_size, ws_size, (size_t)WS_END); grid = -1; return; }
        int dev = 0, cus = 0, per_cu = 0;
        hipGetDevice(&dev); hipDeviceGetAttribute(&cus, hipDeviceAttributeMultiprocessorCount, dev);
        if (hipFuncSetAttribute((const void*)fwd, hipFuncAttributeMaxDynamicSharedMemorySize, LDS_BYTES) != hipSuccess) { fprintf(stderr, "kernel_launch: hipFuncSetAttribute failed\n"); grid = -1; return; }
        if (hipOccupancyMaxActiveBlocksPerMultiprocessor(&per_cu, (const void*)fwd, 512, LDS_BYTES) != hipSuccess || per_cu < 1) { fprintf(stderr, "kernel_launch: occupancy query says %d\n", per_cu); per_cu = 1; }
        (void)hipGetLastError();
        grid = cus;
        if (grid != 256) fprintf(stderr, "kernel_launch: note: %d CUs\n", grid);
    }
    if (grid < 0) return;
    hipMemsetAsync(d_ws, 0, ZERO_BYTES, stream);
    Args a{};
    for (int i = 0; i < 21; ++i) a.in[i] = (const float*)d_in[i];
    a.out = (float*)d_out; a.ws = (unsigned char*)d_ws;
#if MK_COOP
    a.ph_lo = 0; a.ph_hi = NPHASE;
    void* args[] = {&a};
    hipError_t e = hipLaunchCooperativeKernel((const void*)fwd, dim3(grid), dim3(512), args, LDS_BYTES, stream);
    if (e != hipSuccess) fprintf(stderr, "kernel_launch: cooperative launch failed: %s (grid %d)\n", hipGetErrorString(e), grid);
#else
    for (int p = 0; p < NPHASE; ++p) { a.ph_lo = p; a.ph_hi = p + 1; hipLaunchKernelGGL(fwd, dim3(grid), dim3(512), LDS_BYTES, stream, a); }
#endif
}
```
